# Optimizing an MI355X kernel written in HIP

```python
import jax, jax.numpy as jnp
from jax import lax
import numpy as np

D_MODEL = 1024
BATCH = 8
SEQ = 4096
DEPTH = 4

D_MIX = D_MODEL
HEAD_DIM = 64
D_ATTN = D_MIX // 2
N_HEADS = D_ATTN // HEAD_DIM
D_CONV = D_MIX - D_ATTN
D_IN = 3 * D_ATTN + 2 * D_CONV
CONV_WIDTH = 31
DILATED_BRANCHES = ((128, 1), (512, 4), (2048, 16))
ATTN_BLOCK = 128
N_GROUPS = 4
EXPERTS_PER_GROUP = 8
N_EXPERTS = N_GROUPS * EXPERTS_PER_GROUP
TOP_K_INNER = 2
D_EXPERT = D_MODEL // 2
MOE_BLOCK = 256
NORM_EPS = 1e-6
N_MOD = 6

kernel_name = "hybrid_dilated_attn_conformer_hmoe"


def rms_norm(x, g):
    x32 = x.astype(jnp.float32)
    y = x32 * lax.rsqrt(jnp.mean(x32 * x32, axis=-1, keepdims=True) + NORM_EPS)
    return (y * g.astype(jnp.float32)).astype(x.dtype)


def layer_norm(x, g, b):
    x32 = x.astype(jnp.float32)
    mu = jnp.mean(x32, axis=-1, keepdims=True)
    var = jnp.mean(jnp.square(x32 - mu), axis=-1, keepdims=True)
    y = (x32 - mu) * lax.rsqrt(var + NORM_EPS)
    return (y * g.astype(jnp.float32) + b.astype(jnp.float32)).astype(x.dtype)


def alibi_slopes(n_heads):
    return jnp.asarray(2.0 ** (-8.0 * np.arange(1, n_heads + 1) / n_heads), dtype=jnp.float32)


def dilated_branch(q, k, v, slopes, window, dil):
    B, H, S, Dh = q.shape
    L = S // dil
    n_back = window // dil
    nb = -(-L // ATTN_BLOCK)
    Lp = nb * ATTN_BLOCK

    def to_blocks(t):
        t = t.reshape(B, H, L, dil, Dh).transpose(0, 1, 3, 2, 4)
        t = jnp.pad(t, ((0, 0), (0, 0), (0, 0), (0, Lp - L), (0, 0)))
        return t.reshape(B, H, dil, nb, ATTN_BLOCK, Dh)

    def with_prev(t):
        prev = jnp.pad(t[:, :, :, :-1], ((0, 0), (0, 0), (0, 0), (1, 0), (0, 0), (0, 0)))
        return jnp.concatenate([prev, t], axis=4)

    qb = to_blocks(q)
    kc = with_prev(to_blocks(k))
    vc = with_prev(to_blocks(v))
    s = jnp.einsum('bhrnqd,bhrnkd->bhrnqk', qb, kc,
                   preferred_element_type=jnp.float32) * (HEAD_DIM ** -0.5)
    qi = np.arange(ATTN_BLOCK)[:, None] + ATTN_BLOCK
    ki = np.arange(2 * ATTN_BLOCK)[None, :]
    delta = qi - ki
    blk_ok = (np.arange(nb)[:, None, None] > 0) | (ki[None] >= ATTN_BLOCK)
    valid = (delta >= 0) & (delta <= n_back) & blk_ok
    bias = -slopes[:, None, None] * jnp.asarray(delta * dil, dtype=jnp.float32)
    s = s + bias[None, :, None, None]
    s = jnp.where(valid[None, None, None], s, -jnp.inf)
    m = jnp.max(s, axis=-1)
    p = jnp.exp(s - m[..., None])
    l = jnp.sum(p, axis=-1)
    o = jnp.einsum('bhrnqk,bhrnkd->bhrnqd', p, vc.astype(jnp.float32))

    def from_blocks(t, trailing):
        t = t.reshape((B, H, dil, Lp) + trailing)[:, :, :, :L]
        t = jnp.moveaxis(t, 2, 3)
        return t.reshape((B, H, S) + trailing)

    return from_blocks(o, (Dh,)), from_blocks(m, ()), from_blocks(l, ())


def dilated_attention(q, k, v, slopes):
    outs = [dilated_branch(q, k, v, slopes, w, d) for (w, d) in DILATED_BRANCHES]
    m_all = jnp.stack([m for (_, m, _) in outs])
    m_max = jnp.max(m_all, axis=0)
    num = 0.0
    den = 0.0
    for (o, m, l) in outs:
        a = jnp.exp(m - m_max)
        num = num + a[..., None] * o
        den = den + a * l
    return num / den[..., None]


def conformer_conv(a, b, conv_w, conv_b, ln_g, ln_b):
    u = a * jax.nn.sigmoid(b)
    y = lax.conv_general_dilated(u, conv_w[:, None, :].astype(u.dtype), window_strides=(1,),
                                 padding=[(CONV_WIDTH - 1, 0)],
                                 dimension_numbers=('NWC', 'WIO', 'NWC'),
                                 feature_group_count=D_CONV) + conv_b
    return jax.nn.silu(layer_norm(y, ln_g, ln_b))


def hier_moe(h, w_rg, b_rg, w_re, b_re, w_gate, w_up, w_down):
    B, S, D = h.shape
    T = B * S
    hf = h.reshape(T, D)
    tix = jnp.arange(T)
    g_logits = (hf @ w_rg + b_rg).astype(jnp.float32)
    g_prob = jax.nn.softmax(g_logits, axis=-1)
    grp = jnp.argmax(g_logits, axis=-1)
    p_grp = g_prob[tix, grp]
    e_logits = (hf @ w_re + b_re).astype(jnp.float32).reshape(T, N_GROUPS, EXPERTS_PER_GROUP)
    e_logits = e_logits[tix, grp]
    top_val, top_idx = lax.top_k(e_logits, TOP_K_INNER)
    top_w = jax.nn.softmax(top_val, axis=-1) * p_grp[:, None]

    A = T * TOP_K_INNER
    eid = (grp[:, None] * EXPERTS_PER_GROUP + top_idx).reshape(A).astype(jnp.int32)
    tok = jnp.repeat(tix, TOP_K_INNER).astype(jnp.int32)
    wts = top_w.reshape(A)
    order = jnp.argsort(eid)
    s_eid, s_tok, s_w = eid[order], tok[order], wts[order]
    counts = jnp.bincount(eid, length=N_EXPERTS)
    start = jnp.cumsum(counts) - counts
    padded = ((counts + MOE_BLOCK - 1) // MOE_BLOCK) * MOE_BLOCK
    pad_end = jnp.cumsum(padded)
    pad_start = pad_end - padded
    dest = pad_start[s_eid] + (jnp.arange(A) - start[s_eid])
    P = (-(-A // MOE_BLOCK)) * MOE_BLOCK + N_EXPERTS * MOE_BLOCK
    nblk = P // MOE_BLOCK
    buf_tok = jnp.full((P,), T, dtype=jnp.int32).at[dest].set(s_tok)
    buf_w = jnp.zeros((P,), dtype=jnp.float32).at[dest].set(s_w)
    blk_eid = jnp.clip(jnp.searchsorted(pad_end, jnp.arange(nblk) * MOE_BLOCK, side='right'),
                       0, N_EXPERTS - 1)
    x_pad = jnp.concatenate([hf, jnp.zeros((1, D), hf.dtype)], axis=0)
    xb = x_pad[buf_tok].reshape(nblk, MOE_BLOCK, D)

    def expert_block(args):
        xblk, e = args
        return (jax.nn.silu(xblk @ w_gate[e]) * (xblk @ w_up[e])) @ w_down[e]

    yb = lax.map(expert_block, (xb, blk_eid)).reshape(P, D)
    out = jnp.zeros((T + 1, D), yb.dtype).at[buf_tok].add(yb * buf_w[:, None].astype(yb.dtype))[:T]
    return out.reshape(B, S, D).astype(h.dtype)


def setup_inputs(seed: int = 0) -> dict:
    key = jax.random.key(seed)
    ks = jax.random.split(key, 24)
    f32 = jnp.float32
    nrm = lambda k, shape, s: jax.random.normal(k, shape, f32) * s
    L = DEPTH
    return {
        "x": nrm(ks[0], (BATCH, SEQ, D_MODEL), 1.0),
        "c": nrm(ks[1], (BATCH, D_MODEL), 1.0),
        "w_mod": nrm(ks[2], (L, D_MODEL, N_MOD * D_MODEL), 0.5 * D_MODEL ** -0.5),
        "b_mod": nrm(ks[3], (L, N_MOD * D_MODEL), 0.01),
        "g_norm1": 1.0 + nrm(ks[4], (L, D_MODEL), 0.02),
        "w_in": nrm(ks[5], (L, D_MODEL, D_IN), D_MODEL ** -0.5),
        "conv_w": nrm(ks[6], (L, CONV_WIDTH, D_CONV), CONV_WIDTH ** -0.5),
        "conv_b": nrm(ks[7], (L, D_CONV), 0.01),
        "conv_ln_g": 1.0 + nrm(ks[8], (L, D_CONV), 0.02),
        "conv_ln_b": nrm(ks[9], (L, D_CONV), 0.01),
        "w_out": nrm(ks[10], (L, D_MIX, D_MODEL), D_MIX ** -0.5),
        "g_norm2": 1.0 + nrm(ks[11], (L, D_MODEL), 0.02),
        "w_router_group": nrm(ks[12], (L, D_MODEL, N_GROUPS), D_MODEL ** -0.5),
        "b_router_group": nrm(ks[13], (L, N_GROUPS), 0.01),
        "w_router_expert": nrm(ks[14], (L, D_MODEL, N_EXPERTS), D_MODEL ** -0.5),
        "b_router_expert": nrm(ks[15], (L, N_EXPERTS), 0.01),
        "w_exp_gate": nrm(ks[16], (L, N_EXPERTS, D_MODEL, D_EXPERT), D_MODEL ** -0.5),
        "w_exp_up": nrm(ks[17], (L, N_EXPERTS, D_MODEL, D_EXPERT), D_MODEL ** -0.5),
        "w_exp_down": nrm(ks[18], (L, N_EXPERTS, D_EXPERT, D_MODEL), D_EXPERT ** -0.5),
        "g_final": 1.0 + nrm(ks[19], (D_MODEL,), 0.02),
    }


def reference(x, c, w_mod, b_mod, g_norm1, w_in, conv_w, conv_b, conv_ln_g, conv_ln_b, w_out,
              g_norm2, w_router_group, b_router_group, w_router_expert, b_router_expert,
              w_exp_gate, w_exp_up, w_exp_down, g_final):
    B, S, D = x.shape
    slopes = alibi_slopes(N_HEADS)
    c_act = jax.nn.silu(c)

    def split_heads(t):
        return t.reshape(B, S, N_HEADS, HEAD_DIM).transpose(0, 2, 1, 3)

    for l in range(DEPTH):
        mod = c_act @ w_mod[l] + b_mod[l]
        sh1, sc1, gt1, sh2, sc2, gt2 = jnp.split(mod[:, None, :], N_MOD, axis=-1)

        h = rms_norm(x, g_norm1[l]) * (1.0 + sc1) + sh1
        u = h @ w_in[l]
        q, k, v, ga, gb = jnp.split(
            u, [D_ATTN, 2 * D_ATTN, 3 * D_ATTN, 3 * D_ATTN + D_CONV], axis=-1)
        attn = dilated_attention(split_heads(q), split_heads(k), split_heads(v), slopes)
        attn = attn.transpose(0, 2, 1, 3).reshape(B, S, D_ATTN).astype(x.dtype)
        conv = conformer_conv(ga, gb, conv_w[l], conv_b[l], conv_ln_g[l], conv_ln_b[l])
        mix = jnp.concatenate([attn, conv], axis=-1) @ w_out[l]
        x = x + gt1 * mix

        h2 = rms_norm(x, g_norm2[l]) * (1.0 + sc2) + sh2
        x = x + gt2 * hier_moe(h2, w_router_group[l], b_router_group[l], w_router_expert[l],
                               b_router_expert[l], w_exp_gate[l], w_exp_up[l], w_exp_down[l])

    return rms_norm(x, g_final)
```

```cpp
#include <hip/hip_runtime.h>
#include <cstdio>
#include <cstdint>

#define LAS __attribute__((address_space(3)))
#define GAS __attribute__((address_space(1)))
typedef unsigned short bf16_t;
typedef short bf16x8 __attribute__((ext_vector_type(8)));
typedef short s16x4 __attribute__((ext_vector_type(4)));
typedef float f32x2 __attribute__((ext_vector_type(2)));
typedef float f32x4 __attribute__((ext_vector_type(4)));
typedef float f32x16 __attribute__((ext_vector_type(16)));
typedef unsigned u32x2 __attribute__((ext_vector_type(2)));
typedef unsigned u32x4 __attribute__((ext_vector_type(4)));

constexpr int NB = 8, SEQ = 4096, DM = 1024, NT = NB * SEQ, NL = 4;
constexpr int NH = 8, HD = 64, DA = 512, DC = 512, DIN = 2560, CW = 31;
constexpr int NE = 32, EPG = 8, NGRP = 4, DE = 512, NMOD = 6 * DM;
constexpr int QKVP = 3 * DA;
constexpr int PMAX = 2 * NT + NE * 256;
constexpr int LCAP = NT;
constexpr float EPS = 1e-6f;
constexpr float LOG2E = 1.4426950408889634f;
constexpr float QSCALE = 0.125f * LOG2E;

constexpr size_t MiB = 1u << 20;
constexpr size_t WS_CTL = 0, CTL_BYTES = 96 * 1024;
constexpr size_t WS_MOD = 1 * MiB;
constexpr size_t WS_WR = 2 * MiB;
constexpr size_t WS_TOK = 3 * MiB;
constexpr size_t WS_LIST = 4 * MiB;
constexpr size_t WS_WIN = 8 * MiB;
constexpr size_t WS_WOUT = 28 * MiB;
constexpr size_t WS_WGU = 36 * MiB;
constexpr size_t WS_WD = 292 * MiB;
constexpr size_t WS_H = 420 * MiB;
constexpr size_t WS_ACT = 484 * MiB;
constexpr size_t WS_QKV = 556 * MiB;
constexpr size_t WS_GLU = 652 * MiB;
constexpr size_t WS_MIX = 684 * MiB;
constexpr size_t WS_Y = 556 * MiB;
constexpr size_t WS_X = 748 * MiB;
constexpr size_t WS_H2 = 420 * MiB;
constexpr size_t WS_HP = 876 * MiB;
constexpr size_t WS_ACT1 = WS_ACT, WS_LIST1 = WS_LIST, WS_TOK1 = WS_TOK;
constexpr size_t WS_END = 1020 * MiB;
__device__ __forceinline__ size_t ws_h2(int) { return WS_H2; }
__device__ __forceinline__ size_t ws_act(int l) { return (l & 1) ? WS_ACT1 : WS_ACT; }
__device__ __forceinline__ size_t ws_list(int l) { return (l & 1) ? WS_LIST1 : WS_LIST; }
__device__ __forceinline__ size_t ws_tok(int l) { return (l & 1) ? WS_TOK1 : WS_TOK; }
static_assert(WS_Y + (size_t)PMAX * DM * 2 <= WS_END && WS_ACT + (size_t)PMAX * DE * 2 <= WS_QKV, "ws map");
constexpr int CW_BAR = 4096;
constexpr int CW_CNT = 16384;
constexpr int CW_QBAR = 22528;
constexpr int CW_CVQ = 20992;
constexpr int CW_FLAG = 20480;

constexpr int LDS_SCRATCH = 131072;
constexpr int LC_BAR = LDS_SCRATCH;
constexpr int LC_TPRE = LDS_SCRATCH + 64;
constexpr int LC_CNT = LDS_SCRATCH + 256;
constexpr int LC_ROWTAB = LDS_SCRATCH + 1024;
constexpr int MAXU = 6;
constexpr int LC_ORD = LC_ROWTAB + MAXU * 1024;
constexpr int LDS_BYTES = 147456;

__device__ __forceinline__ unsigned cvt_pk_bf16(float lo, float hi) {
    typedef __bf16 b2 __attribute__((ext_vector_type(2)));
    f32x2 v = {lo, hi}; b2 b = __builtin_convertvector(v, b2); return __builtin_bit_cast(unsigned, b);
}
__device__ __forceinline__ float bf_lo(unsigned u) { return __uint_as_float(u << 16); }
__device__ __forceinline__ float bf_hi(unsigned u) { return __uint_as_float(u & 0xffff0000u); }
__device__ __forceinline__ float wave_sum(float v) {
#pragma unroll
    for (int o = 1; o < 64; o <<= 1) v += __shfl_xor(v, o);
    return v;
}
__device__ __forceinline__ float fast_exp2(float x) { return __builtin_amdgcn_exp2f(x); }
__device__ __forceinline__ float fast_rcp(float x) { return __builtin_amdgcn_rcpf(x); }
__device__ __forceinline__ float sigmoidf_fast(float x) { return fast_rcp(1.0f + fast_exp2(-x * LOG2E)); }
__device__ __forceinline__ int opaque_s(int x) { asm volatile("" : "+s"(x)); return x; }
__device__ __forceinline__ int opaque_v(int x) { asm volatile("" : "+v"(x)); return x; }
__device__ __forceinline__ int crow(int r, int hi) { return (r & 3) + 8 * (r >> 2) + 4 * hi; }

__device__ __forceinline__ f32x4 ld_x4(const float* xf, const bf16_t* xb, size_t idx) {
    if (xf) return *(const f32x4*)(xf + idx);
    const u32x2 u = *(const u32x2*)(xb + idx);
    return (f32x4){bf_lo(u.x), bf_hi(u.x), bf_lo(u.y), bf_hi(u.y)};
}
__device__ __forceinline__ void st_x4(bf16_t* xb, size_t idx, f32x4 v) { u32x2 o; o.x = cvt_pk_bf16(v[0], v[1]); o.y = cvt_pk_bf16(v[2], v[3]); *(u32x2*)(xb + idx) = o; }
#define XB_TMO      128
#define XB_XCNT(j)  (256  + 64 * (j))
#define XB_XSUB(j)  (1280 + 64 * (j))
#define XB_XGEN(j)  (2304 + 64 * (j))
#define XB_TOP      3328
#define XB_TOPGEN   3392
#define XCD_BAR_WORDS 3456
#define XB_SPIN_CAP (1u << 18)
__device__ __forceinline__ unsigned xb_ld(unsigned* p)              { return __hip_atomic_load(p, __ATOMIC_RELAXED, __HIP_MEMORY_SCOPE_AGENT); }
__device__ __forceinline__ unsigned xb_add(unsigned* p, unsigned v) { return __hip_atomic_fetch_add(p, v, __ATOMIC_RELAXED, __HIP_MEMORY_SCOPE_AGENT); }
__device__ __forceinline__ unsigned xb_xcc_id() { return (unsigned)__builtin_amdgcn_s_getreg((3 << 11) | 20) & 0xFu; }
#define XB_SPIN(cond, bar) do { unsigned _sp = 0; while (cond) { __builtin_amdgcn_s_sleep(1); \
    if ((++_sp & 255u) == 0u) { if (xb_ld(&(bar)[XB_TMO])) break; if (_sp > XB_SPIN_CAP) { atomicAdd(&(bar)[XB_TMO], 1u); break; } } } } while (0)
__device__ __forceinline__ bool is_thread0(int w0) { return w0 == 0 && __builtin_amdgcn_mbcnt_hi(~0u, __builtin_amdgcn_mbcnt_lo(~0u, 0u)) == 0u; }
struct XcdBarrier { unsigned* bar; unsigned x; volatile LAS unsigned* st; int w0; };
__device__ __forceinline__ XcdBarrier xcd_barrier_post(unsigned* bar, volatile LAS unsigned* st) {
    XcdBarrier b; b.bar = bar; b.x = xb_xcc_id(); b.st = st; b.w0 = __builtin_amdgcn_readfirstlane((int)(threadIdx.x >> 6));
    if (threadIdx.x == 0) (void)xb_add(&bar[XB_XCNT(b.x)], 1u);
    return b;
}
__device__ __forceinline__ void xcd_barrier_complete(unsigned* bar, unsigned x, unsigned& nloc, unsigned& nx) {
    const unsigned G = gridDim.x * gridDim.y * gridDim.z;
    unsigned sum, cnt, mine, sp = 0u;
    for (;;) {
        sum = 0u; cnt = 0u; mine = 0u;
#pragma unroll
        for (unsigned j = 0; j < 16; ++j) { const unsigned c = xb_ld(&bar[XB_XCNT(j)]); sum += c; cnt += (c > 0u) ? 1u : 0u; mine = (j == x) ? c : mine; }
        if (sum == G) break;
        __builtin_amdgcn_s_sleep(1);
        if ((++sp & 255u) == 0u) { if (xb_ld(&bar[XB_TMO])) break; if (sp > XB_SPIN_CAP) { atomicAdd(&bar[XB_TMO], 1u); break; } }
    }
    nloc = mine > 0u ? mine : 1u; nx = cnt > 0u ? cnt : 1u;
}
__device__ __forceinline__ void xcd_barrier(const XcdBarrier& b) {
    asm volatile("s_waitcnt vmcnt(0)" ::: "memory");
    __syncthreads();
    if (threadIdx.x == 0) {
        unsigned* bar = b.bar;
        __builtin_amdgcn_s_waitcnt(0);
        unsigned nloc = b.st[0], nx = b.st[1];
        if (nloc == 0u) { xcd_barrier_complete(bar, b.x, nloc, nx); b.st[0] = nloc; b.st[1] = nx; }
        const unsigned old = xb_add(&bar[XB_XSUB(b.x)], 1u);
        const unsigned gen = old / nloc;
        if (old + 1u == (gen + 1u) * nloc) {
            __builtin_amdgcn_fence(__ATOMIC_RELEASE, "agent");
            asm volatile("s_waitcnt vmcnt(0)" ::: "memory");
            const unsigned og = xb_add(&bar[XB_TOP], 1u);
            const unsigned tg = og / nx;
            if (og + 1u == (tg + 1u) * nx) xb_add(&bar[XB_TOPGEN], 1u);
            else XB_SPIN(xb_ld(&bar[XB_TOPGEN]) == tg, bar);
            __builtin_amdgcn_fence(__ATOMIC_ACQUIRE, "agent");
            xb_add(&bar[XB_XGEN(b.x)], 1u);
            asm volatile("s_waitcnt vmcnt(0)" ::: "memory");
        } else {
            XB_SPIN(xb_ld(&bar[XB_XGEN(b.x)]) == gen, bar);
            __builtin_amdgcn_fence(__ATOMIC_ACQUIRE, "agent");
            asm volatile("s_waitcnt vmcnt(0)" ::: "memory");
        }
    }
    __syncthreads();
}

__device__ __forceinline__ void quad_barrier(unsigned* ctl, int vcu, unsigned gen, int w0) {
    asm volatile("s_waitcnt vmcnt(0)" ::: "memory");
    __syncthreads();
    if (threadIdx.x == 0) {
        const bool q4 = (gridDim.x & 3u) == 0u;
        unsigned* c = ctl + CW_QBAR + (unsigned)opaque_s(q4 ? (vcu >> 2) * 32 : 0); const unsigned n = q4 ? 4u : gridDim.x;
        __builtin_amdgcn_fence(__ATOMIC_RELEASE, "agent");
        (void)__hip_atomic_fetch_add(c, 1u, __ATOMIC_RELAXED, __HIP_MEMORY_SCOPE_AGENT);
        const unsigned target = (gen + 1u) * n;
        unsigned sp = 0u;
        while (__hip_atomic_load(c, __ATOMIC_RELAXED, __HIP_MEMORY_SCOPE_AGENT) < target) { __builtin_amdgcn_s_sleep(1); if (++sp > (1u << 22)) break; }
        __builtin_amdgcn_fence(__ATOMIC_ACQUIRE, "agent");
        asm volatile("s_waitcnt vmcnt(0)" ::: "memory");
    }
    __syncthreads();
}
namespace pg8 {
constexpr int BM = 256, BK = 64, HALF = 128, HTB = HALF * BK * 2, STAGE_BYTES = 8 * HTB, NXCD = 8, WGM = 8;
__host__ __device__ __forceinline__ int lds_byte(int r, int c) { const int st = (r >> 4) * 2 + (c >> 5), rr = r & 15, cc = c & 31, ob = rr * 64 + cc * 2; return st * 1024 + (ob ^ (((ob >> 9) & 1) << 5)); }
__host__ __device__ __forceinline__ void stage_rc(int b, int& R, int& C) { const int st = b / 1024, sb = b % 1024, swz = sb ^ (((sb >> 9) & 1) << 5); R = (st >> 1) * 16 + swz / 64; C = (st & 1) * 32 + (swz % 64) / 2; }
__host__ __device__ __forceinline__ int perm32(int rho) { const int n = rho >> 4, i = rho & 15; return 8 * (i >> 2) + 4 * n + (i & 3); }
struct Unit { int pm, pn, e, half; };

template <class Epi, class Sched>
__device__ __forceinline__ void gemm_phase(LAS unsigned char* lds, const Sched& S, const Epi& E, const char* Amat, const int K, const int tid_) {
    const int tid = tid_, wid = __builtin_amdgcn_readfirstlane(tid >> 6), lane = tid & 63, wr = wid >> 2, wc = wid & 3, fr = lane & 15, fq = lane >> 4;
    const int nt = K / BK;
    constexpr bool GATHER = Sched::GATHER;
    int Rr[2]; unsigned voffA[2], voffB[2];
#pragma unroll
    for (int i = 0; i < 2; ++i) { int R, C; stage_rc(tid * 16 + i * 8192, R, C); const int Rb = Epi::PERM ? ((R & ~31) + perm32(R & 31)) : R;
        Rr[i] = R; voffA[i] = GATHER ? (unsigned)C * 2u : (unsigned)(R * K + C) * 2u; voffB[i] = (unsigned)(Rb * K + C) * 2u; }
    const size_t kstep = (size_t)(BK * 2);
    const size_t hstepB = (size_t)HALF * K * 2;
    const unsigned rowbytes = (unsigned)(K * 2);
    const unsigned ldsw = (unsigned)wid * 1024u;
    const int aoff = lds_byte(wr * 64 + fr, fq * 8), boff = lds_byte(wc * 32 + fr, fq * 8);
#define PG8_SA(b, h) (((b) * 2 + (h)) * HTB)
#define PG8_SB(b, h) ((4 + (b) * 2 + (h)) * HTB)
#define PG8_STAGE_B(bufoff, gbase) do { _Pragma("unroll") for (int _i = 0; _i < 2; ++_i) \
        __builtin_amdgcn_global_load_lds((const unsigned*)((const char*)(gbase) + voffB[_i]), (LAS unsigned*)(lds + (bufoff) + ldsw + _i * 8192), 16, 0, 0); } while (0)
#define PG8_STAGE_A(bufoff, kb, us, ub, h) do { \
        if constexpr (GATHER) { \
            const unsigned _t0 = (unsigned)S.rowtab[(us) * 256 + (h) * HALF + Rr[0]], _t1 = (unsigned)S.rowtab[(us) * 256 + (h) * HALF + Rr[1]]; \
            __builtin_amdgcn_global_load_lds((const unsigned*)(Amat + (kb) + (_t0 * rowbytes + voffA[0])), (LAS unsigned*)(lds + (bufoff) + ldsw), 16, 0, 0); \
            __builtin_amdgcn_global_load_lds((const unsigned*)(Amat + (kb) + (_t1 * rowbytes + voffA[1])), (LAS unsigned*)(lds + (bufoff) + ldsw + 8192), 16, 0, 0); \
        } else { \
            const char* _b = Amat + (ub) + (size_t)(h) * hstepB + (kb); \
            __builtin_amdgcn_global_load_lds((const unsigned*)(_b + voffA[0]), (LAS unsigned*)(lds + (bufoff) + ldsw), 16, 0, 0); \
            __builtin_amdgcn_global_load_lds((const unsigned*)(_b + voffA[1]), (LAS unsigned*)(lds + (bufoff) + ldsw + 8192), 16, 0, 0); } } while (0)
#define PG8_LDA(dst, b, h) do { _Pragma("unroll") for (int m = 0; m < 4; ++m) _Pragma("unroll") for (int k = 0; k < 2; ++k) dst[m][k] = *(const LAS bf16x8*)(lds + PG8_SA(b, h) + aoff + m * 2048 + k * 1024); } while (0)
#define PG8_LDB(dst, b, h) do { _Pragma("unroll") for (int n = 0; n < 2; ++n) _Pragma("unroll") for (int k = 0; k < 2; ++k) dst[n][k] = *(const LAS bf16x8*)(lds + PG8_SB(b, h) + boff + n * 2048 + k * 1024); } while (0)
#define PG8_MMA(ai, bj, At, Bt) do { __builtin_amdgcn_s_setprio(1); _Pragma("unroll") for (int m = 0; m < 4; ++m) _Pragma("unroll") for (int n = 0; n < 2; ++n) _Pragma("unroll") for (int k = 0; k < 2; ++k) \
        acc[ai][bj][m][n] = __builtin_amdgcn_mfma_f32_16x16x32_bf16(Bt[n][k], At[m][k], acc[ai][bj][m][n], 0, 0, 0); __builtin_amdgcn_s_setprio(0); } while (0)
#define PG8_WAIT_V(n) asm volatile("s_waitcnt vmcnt(" #n ")" ::: "memory")
#define PG8_WAIT_L(n) asm volatile("s_waitcnt lgkmcnt(" #n ")" ::: "memory")
#define PG8_BAR __builtin_amdgcn_s_barrier()
#define PG8_SCHED __builtin_amdgcn_sched_barrier(0)
    Unit cur, nxt; int ui = 0;
    if (!S.next(0, cur)) return;
    f32x4 acc[2][2][4][2];
#pragma unroll
    for (int a = 0; a < 2; ++a)
#pragma unroll
        for (int b = 0; b < 2; ++b)
#pragma unroll
            for (int m = 0; m < 4; ++m)
#pragma unroll
                for (int n = 0; n < 2; ++n) acc[a][b][m][n] = (f32x4){0.f, 0.f, 0.f, 0.f};
    bf16x8 At[4][2], B0[2][2], B1[2][2];
    size_t cU = S.a_ubase(cur);
    const char* cB = S.b_base(cur);
    PG8_STAGE_B(PG8_SB(0, 0), cB); PG8_STAGE_B(PG8_SB(0, 1), cB + hstepB); PG8_STAGE_A(PG8_SA(0, 0), 0, 0, cU, 0); PG8_STAGE_A(PG8_SA(0, 1), 0, 0, cU, 1);
    if (wr == 1) PG8_BAR;
    PG8_WAIT_V(2); PG8_BAR;
    PG8_STAGE_B(PG8_SB(1, 0), cB + kstep); PG8_STAGE_A(PG8_SA(1, 0), kstep, 0, cU, 0); PG8_STAGE_B(PG8_SB(1, 1), cB + hstepB + kstep);
    PG8_WAIT_V(6); PG8_BAR;
    for (;;) {
        const bool has_next = S.next(ui + 1, nxt);
        const char* nB = cB; size_t nU = cU; int nS = ui;
        if (has_next) { nB = S.b_base(nxt); nU = S.a_ubase(nxt); nS = ui + 1; }
        const bool fullu = !Sched::HALFABLE || !cur.half;
        for (int t = 0; t < nt; t += 2) {
            const bool last = (t == nt - 2);
            const size_t k1 = (size_t)(t + 1) * kstep;
            const size_t k2 = last ? (size_t)0 : (size_t)(t + 2) * kstep;
            const size_t k3 = k2 + kstep;
            const char* b2 = last ? nB : cB + (size_t)(t + 2) * kstep; const char* b3 = b2 + kstep;
            const size_t u2 = last ? nU : cU; const int s2 = last ? nS : ui;
            PG8_LDB(B0, 0, 0); PG8_LDB(B1, 0, 1); PG8_SCHED; PG8_LDA(At, 0, 0); PG8_STAGE_A(PG8_SA(1, 1), k1, ui, cU, 1);
            PG8_WAIT_V(8); PG8_WAIT_L(0); PG8_BAR; PG8_MMA(0, 0, At, B0); PG8_MMA(0, 1, At, B1); PG8_BAR; PG8_SCHED;
            if (fullu) PG8_LDA(At, 0, 1); PG8_STAGE_B(PG8_SB(0, 0), b2); PG8_STAGE_B(PG8_SB(0, 1), b2 + hstepB); PG8_STAGE_A(PG8_SA(0, 0), k2, s2, u2, 0);
            PG8_WAIT_V(8); PG8_WAIT_L(0); PG8_BAR; if (fullu) { PG8_MMA(1, 0, At, B0); PG8_MMA(1, 1, At, B1); } PG8_BAR; PG8_SCHED;
            PG8_LDB(B0, 1, 0); PG8_LDB(B1, 1, 1); PG8_SCHED; PG8_LDA(At, 1, 0); PG8_STAGE_A(PG8_SA(0, 1), k2, s2, u2, 1);
            PG8_WAIT_V(8); PG8_WAIT_L(0); PG8_BAR; PG8_MMA(0, 0, At, B0); PG8_MMA(0, 1, At, B1); PG8_BAR; PG8_SCHED;
            if (fullu) PG8_LDA(At, 1, 1); PG8_STAGE_B(PG8_SB(1, 0), b3); PG8_STAGE_B(PG8_SB(1, 1), b3 + hstepB); PG8_STAGE_A(PG8_SA(1, 0), k3, s2, u2, 0);
            PG8_WAIT_V(8); PG8_WAIT_L(0); PG8_BAR; if (fullu) { PG8_MMA(1, 0, At, B0); PG8_MMA(1, 1, At, B1); } PG8_BAR; PG8_SCHED;
        }
        if (wr == 0) PG8_BAR;
        E(acc, cur, wr, wc, fr, fq);
        if (!has_next) break;
#pragma unroll
        for (int a = 0; a < 2; ++a)
#pragma unroll
            for (int b = 0; b < 2; ++b)
#pragma unroll
                for (int m = 0; m < 4; ++m)
#pragma unroll
                    for (int n = 0; n < 2; ++n) acc[a][b][m][n] = (f32x4){0.f, 0.f, 0.f, 0.f};
        cur = nxt; cB = nB; cU = nU; ++ui;
        if (wr == 1) PG8_BAR;
    }
    PG8_WAIT_V(0);
    PG8_BAR;
#undef PG8_SA
#undef PG8_SB
#undef PG8_STAGE_A
#undef PG8_STAGE_B
#undef PG8_LDA
#undef PG8_LDB
#undef PG8_MMA
#undef PG8_WAIT_V
#undef PG8_WAIT_L
#undef PG8_BAR
#undef PG8_SCHED
}

struct DenseOrder {
    int nM, nN, nwg, G, c, K; const char* Bt;
    __device__ void init(int M, int N, int K_, int G_, int c_, const void* Bt_) { rowtab = nullptr; nM = M / BM; nN = N / BM; nwg = nM * nN; G = G_; c = c_; K = K_; Bt = (const char*)Bt_; }
    __device__ __forceinline__ bool next(int i, Unit& u) const {
        const long L = (long)i * G + c; if (L >= nwg) return false;
        int wgid = (int)L; { const int q = nwg / NXCD, r = nwg % NXCD, xcd = wgid % NXCD, off = wgid / NXCD; wgid = (xcd < r ? xcd * (q + 1) : r * (q + 1) + (xcd - r) * q) + off; }
        const int nig = WGM * nN, gid = wgid / nig, fm = gid * WGM, gsz = (nM - fm) < WGM ? (nM - fm) : WGM;
        u.pm = fm + ((wgid % nig) % gsz); u.pn = (wgid % nig) / gsz; u.e = 0; u.half = 0; return true;
    }
    static constexpr bool GATHER = false, HALFABLE = false; const LAS int* rowtab;
    __device__ __forceinline__ size_t a_ubase(const Unit& u) const { return (size_t)u.pm * BM * K * 2; }
    __device__ __forceinline__ const char* b_base(const Unit& u) const { return Bt + (size_t)u.pn * BM * K * 2; }
};
template <bool GATHER_>
struct MoeOrder {
    static constexpr bool GATHER = GATHER_, HALFABLE = true;
    const LAS int* tpre; const LAS int* rowtab; int nN, G, vcu, K; const char* Bt; size_t estride;
    const LAS int* ord; int nfu, tmap, C4, T4;
    const unsigned* flags;
    __device__ __forceinline__ void init_order() {
        const int F4 = tpre[NE + 1] * nN; T4 = tpre[NE] * nN;
        const int rem = F4 % G; C4 = (2 * rem >= G) ? F4 : F4 - rem;
        nfu = vcu < C4 ? (C4 - 1 - vcu) / G + 1 : 0;
        tmap = (G % 8 == 0) ? (vcu % (G / 8)) * 8 + vcu / (G / 8) : vcu;
    }
    __device__ __forceinline__ bool next(int i, Unit& u) const {
        int U;
        if (i < nfu) U = i * G + vcu; else { U = C4 + (i - nfu) * G + tmap; if (U >= T4) return false;
            if (flags) {
                const unsigned* f = flags + (U - C4) / nN;
#pragma unroll 1
                for (int sp = 0; sp < (1 << 20); ++sp) { if (__hip_atomic_load(f, __ATOMIC_RELAXED, __HIP_MEMORY_SCOPE_AGENT) >= (unsigned)nN) break; __builtin_amdgcn_s_sleep(2); }
                __builtin_amdgcn_fence(__ATOMIC_ACQUIRE, "agent");
            } }
        const int g = U / nN; u.pn = U - g * nN;
        const int o = ord[g], e = o & 255;
        u.e = e; u.pm = tpre[e] + ((o >> 8) & 4095); u.half = o >> 20; return true;
    }
    __device__ __forceinline__ size_t a_ubase(const Unit& u) const { return (size_t)u.pm * BM * K * 2; }
    __device__ __forceinline__ const char* b_base(const Unit& u) const { return Bt + (size_t)u.e * estride + (size_t)u.pn * BM * K * 2; }
};

struct EpiIn {
    static constexpr bool PERM = true;
    bf16_t* QKV; bf16_t* GLU;
    __device__ __forceinline__ void operator()(const f32x4 (&acc)[2][2][4][2], const Unit& u, int wr, int wc, int fr, int fq) const {
        const int row0 = u.pm * BM + wr * 64 + fr;
        if (u.pn < 6) {
            const float sc = (u.pn < 2) ? QSCALE : 1.0f;
            const int col0 = u.pn * BM + wc * 32 + 8 * fq;
#pragma unroll
            for (int ai = 0; ai < 2; ++ai)
#pragma unroll
                for (int m = 0; m < 4; ++m) { bf16_t* rowp = QKV + (size_t)(row0 + ai * HALF + m * 16) * QKVP + col0;
#pragma unroll
                    for (int bj = 0; bj < 2; ++bj) { const f32x4 v0 = acc[ai][bj][m][0] * sc, v1 = acc[ai][bj][m][1] * sc;
                        u32x4 w; w.x = cvt_pk_bf16(v0[0], v0[1]); w.y = cvt_pk_bf16(v0[2], v0[3]); w.z = cvt_pk_bf16(v1[0], v1[1]); w.w = cvt_pk_bf16(v1[2], v1[3]);
                        *(u32x4*)(rowp + bj * HALF) = w; } }
        } else {
            const int col0 = (u.pn - 6) * HALF + wc * 32 + 8 * fq;
#pragma unroll
            for (int ai = 0; ai < 2; ++ai)
#pragma unroll
                for (int m = 0; m < 4; ++m) { bf16_t* rowp = GLU + (size_t)(row0 + ai * HALF + m * 16) * DC + col0;
                    float o[8];
#pragma unroll
                    for (int n = 0; n < 2; ++n)
#pragma unroll
                        for (int j = 0; j < 4; ++j) o[n * 4 + j] = acc[ai][0][m][n][j] * sigmoidf_fast(acc[ai][1][m][n][j]);
                    u32x4 w; w.x = cvt_pk_bf16(o[0], o[1]); w.y = cvt_pk_bf16(o[2], o[3]); w.z = cvt_pk_bf16(o[4], o[5]); w.w = cvt_pk_bf16(o[6], o[7]);
                    *(u32x4*)rowp = w; }
        }
    }
};
struct EpiResid {
    static constexpr bool PERM = true;
    const float* xf; bf16_t* X; const float* gate;
    __device__ __forceinline__ void operator()(const f32x4 (&acc)[2][2][4][2], const Unit& u, int wr, int wc, int fr, int fq) const {
        const int row0 = u.pm * BM + wr * 64 + fr, col0 = u.pn * BM + wc * 32 + 8 * fq;
        const float* g = gate + (size_t)((u.pm * BM) / SEQ) * NMOD + col0;
        f32x4 gv[2][2];
#pragma unroll
        for (int bj = 0; bj < 2; ++bj)
#pragma unroll
            for (int n = 0; n < 2; ++n) gv[bj][n] = *(const f32x4*)(g + bj * HALF + n * 4);
        if (xf) {
#pragma unroll
            for (int ai = 0; ai < 2; ++ai)
#pragma unroll
                for (int mp = 0; mp < 4; mp += 2) {
                    f32x4 xin[2][2][2];
#pragma unroll
                    for (int mm = 0; mm < 2; ++mm)
#pragma unroll
                        for (int bj = 0; bj < 2; ++bj) { const size_t ro = (size_t)(row0 + ai * HALF + (mp + mm) * 16) * DM + col0 + bj * HALF;
                            xin[mm][bj][0] = *(const f32x4*)(xf + ro); xin[mm][bj][1] = *(const f32x4*)(xf + ro + 4); }
#pragma unroll
                    for (int mm = 0; mm < 2; ++mm)
#pragma unroll
                        for (int bj = 0; bj < 2; ++bj) { const size_t ro = (size_t)(row0 + ai * HALF + (mp + mm) * 16) * DM + col0 + bj * HALF;
                            const f32x4 v0 = xin[mm][bj][0] + gv[bj][0] * acc[ai][bj][mp + mm][0], v1 = xin[mm][bj][1] + gv[bj][1] * acc[ai][bj][mp + mm][1];
                            u32x4 w; w.x = cvt_pk_bf16(v0[0], v0[1]); w.y = cvt_pk_bf16(v0[2], v0[3]); w.z = cvt_pk_bf16(v1[0], v1[1]); w.w = cvt_pk_bf16(v1[2], v1[3]);
                            *(u32x4*)(X + ro) = w; }
                }
        } else {
#pragma unroll
            for (int ai = 0; ai < 2; ++ai) {
                u32x4 ux[4][2];
#pragma unroll
                for (int m = 0; m < 4; ++m)
#pragma unroll
                    for (int bj = 0; bj < 2; ++bj) ux[m][bj] = *(const u32x4*)(X + (size_t)(row0 + ai * HALF + m * 16) * DM + col0 + bj * HALF);
#pragma unroll
                for (int m = 0; m < 4; ++m)
#pragma unroll
                    for (int bj = 0; bj < 2; ++bj) { const u32x4 t = ux[m][bj];
                        const f32x4 x0 = (f32x4){bf_lo(t.x), bf_hi(t.x), bf_lo(t.y), bf_hi(t.y)}, x1 = (f32x4){bf_lo(t.z), bf_hi(t.z), bf_lo(t.w), bf_hi(t.w)};
                        const f32x4 v0 = x0 + gv[bj][0] * acc[ai][bj][m][0], v1 = x1 + gv[bj][1] * acc[ai][bj][m][1];
                        u32x4 w; w.x = cvt_pk_bf16(v0[0], v0[1]); w.y = cvt_pk_bf16(v0[2], v0[3]); w.z = cvt_pk_bf16(v1[0], v1[1]); w.w = cvt_pk_bf16(v1[2], v1[3]);
                        *(u32x4*)(X + (size_t)(row0 + ai * HALF + m * 16) * DM + col0 + bj * HALF) = w; }
            }
        }
    }
};
struct EpiSwiglu {
    static constexpr bool PERM = true;
    bf16_t* ACT;
    __device__ __forceinline__ void operator()(const f32x4 (&acc)[2][2][4][2], const Unit& u, int wr, int wc, int fr, int fq) const {
        const int row0 = u.pm * BM + wr * 64 + fr, col0 = u.pn * HALF + wc * 32 + 8 * fq;
#pragma unroll
        for (int ai = 0; ai < 2; ++ai) { if (ai == 1 && u.half) break;
#pragma unroll
            for (int m = 0; m < 4; ++m) { bf16_t* rowp = ACT + (size_t)(row0 + ai * HALF + m * 16) * DE + col0;
                float o[8];
#pragma unroll
                for (int n = 0; n < 2; ++n)
#pragma unroll
                    for (int j = 0; j < 4; ++j) { const float g = acc[ai][0][m][n][j]; o[n * 4 + j] = g * sigmoidf_fast(g) * acc[ai][1][m][n][j]; }
                u32x4 w; w.x = cvt_pk_bf16(o[0], o[1]); w.y = cvt_pk_bf16(o[2], o[3]); w.z = cvt_pk_bf16(o[4], o[5]); w.w = cvt_pk_bf16(o[6], o[7]);
                *(u32x4*)rowp = w; } }
    }
};
struct EpiY {
    static constexpr bool PERM = true;
    bf16_t* Y;
    __device__ __forceinline__ void operator()(const f32x4 (&acc)[2][2][4][2], const Unit& u, int wr, int wc, int fr, int fq) const {
        const int row0 = u.pm * BM + wr * 64 + fr, col0 = u.pn * BM + wc * 32 + 8 * fq;
#pragma unroll
        for (int ai = 0; ai < 2; ++ai) { if (ai == 1 && u.half) break;
#pragma unroll
            for (int m = 0; m < 4; ++m) { bf16_t* rowp = Y + (size_t)(row0 + ai * HALF + m * 16) * DM + col0;
#pragma unroll
                for (int bj = 0; bj < 2; ++bj) { const f32x4 v0 = acc[ai][bj][m][0], v1 = acc[ai][bj][m][1];
                    u32x4 w; w.x = cvt_pk_bf16(v0[0], v0[1]); w.y = cvt_pk_bf16(v0[2], v0[3]); w.z = cvt_pk_bf16(v1[0], v1[1]); w.w = cvt_pk_bf16(v1[2], v1[3]);
                    *(u32x4*)(rowp + bj * HALF) = w; } } }
    }
};
}

struct Params {
    const float* in[20];
    float* out;
    unsigned char* ws;
    int ph_lo, ph_hi;
};
enum { I_X = 0, I_C, I_WMOD, I_BMOD, I_G1, I_WIN, I_CONVW, I_CONVB, I_LNG, I_LNB, I_WOUT, I_G2, I_WRG, I_BRG, I_WRE, I_BRE, I_WEG, I_WEU, I_WED, I_GF };

struct Frame {
    LAS unsigned char* lds;
    int tid, lane, wave, vcu, G;
    unsigned char* ws;
    unsigned* ctl;
};

struct CvItem { const float* W; bf16_t* WT; int K, N, k0, n0, drow0; };
__device__ __forceinline__ void cv_load(const CvItem& d, f32x4 (&v)[8], int lane) {
    const int kr = lane >> 3, nc = lane & 7;
#pragma unroll
    for (int i = 0; i < 8; ++i) v[i] = *(const f32x4*)(d.W + (size_t)(d.k0 + 8 * i + kr) * d.N + d.n0 + 4 * nc);
}
__device__ __forceinline__ void cv_finish(const CvItem& d, const f32x4 (&v)[8], LAS float* scr, int lane) {
    const int kr = lane >> 3, nc = lane & 7;
#pragma unroll
    for (int i = 0; i < 8; ++i) { LAS float* p = scr + (8 * i + kr) * 33 + 4 * nc; p[0] = v[i][0]; p[1] = v[i][1]; p[2] = v[i][2]; p[3] = v[i][3]; }
    asm volatile("s_waitcnt lgkmcnt(0)" ::: "memory");
    const int c = lane & 7;
#pragma unroll
    for (int j = 0; j < 4; ++j) { const int n = (lane >> 3) + 8 * j; const LAS float* s = scr + (8 * c) * 33 + n;
        u32x4 o; o.x = cvt_pk_bf16(s[0 * 33], s[1 * 33]); o.y = cvt_pk_bf16(s[2 * 33], s[3 * 33]); o.z = cvt_pk_bf16(s[4 * 33], s[5 * 33]); o.w = cvt_pk_bf16(s[6 * 33], s[7 * 33]);
        *(u32x4*)(d.WT + (size_t)(d.drow0 + n) * d.K + d.k0 + 8 * c) = o; }
    asm volatile("s_waitcnt lgkmcnt(0)" ::: "memory");
}
__device__ __forceinline__ int win_row(int n) {
    if (n < 1536) return n;
    const int c = n - 1536; if (c < 512) return 1536 + (c >> 7) * 256 + (c & 127);
    const int j = c - 512; return 1536 + (j >> 7) * 256 + 128 + (j & 127);
}
#ifndef CONV_CV
#define CONV_CV 1
#endif
constexpr int CV_I_IN = 16 * 80, CV_I_OUT = 16 * 32, CV_I_G = 16 * 16, CV_I_D = 8 * 32;
constexpr int CV_PER_E = 2 * CV_I_G + CV_I_D, CV_PER_L = CV_I_IN + CV_I_OUT + NE * CV_PER_E;
constexpr int CV_PER_UNIT = 2;
constexpr int CV_NCONV = 8192 * CV_PER_UNIT;
#ifndef CV_NH
#define CV_NH 6144
#endif
constexpr int CV_NDELEG = CV_NCONV + CV_NH, CV_REST = CV_PER_L - CV_NDELEG, CV_NP0 = CV_PER_L + (NL - 1) * CV_REST;
static_assert(CV_NH % 2 == 0 && CV_REST > 0, "H-tail share");
static_assert(CV_PER_L % 8 == 0 && CV_NDELEG % 8 == 0, "patches of 8 items");
#define CV_KN(r, NBK) const int q_ = (r) >> 3, s_ = (r) & 7, kb = 2 * (q_ / ((NBK) / 4)) + (s_ >> 2), nb = 4 * (q_ % ((NBK) / 4)) + (s_ & 3)
__device__ __forceinline__ CvItem cv_describe(const Params& P, unsigned char* ws, int it) {
    const int l = it / CV_PER_L; int r = it - l * CV_PER_L;
    if (r < CV_I_IN) { CV_KN(r, 80);
        return CvItem{P.in[opaque_s(I_WIN)] + (size_t)l * DM * DIN, (bf16_t*)(ws + WS_WIN) + (size_t)l * DIN * DM, DM, DIN, kb * 64, nb * 32, win_row(nb * 32)}; }
    r -= CV_I_IN;
    if (r < CV_I_OUT) { CV_KN(r, 32);
        return CvItem{P.in[opaque_s(I_WOUT)] + (size_t)l * DM * DM, (bf16_t*)(ws + WS_WOUT) + (size_t)l * DM * DM, DM, DM, kb * 64, nb * 32, nb * 32}; }
    r -= CV_I_OUT;
    const int e = r / CV_PER_E; r -= e * CV_PER_E; const size_t le = (size_t)l * NE + e;
    if (r < CV_I_G) { CV_KN(r, 16); const int n0 = nb * 32;
        return CvItem{P.in[opaque_s(I_WEG)] + le * DM * DE, (bf16_t*)(ws + WS_WGU) + le * DM * DM, DM, DE, kb * 64, n0, (n0 >> 7) * 256 + (n0 & 127)}; }
    r -= CV_I_G;
    if (r < CV_I_G) { CV_KN(r, 16); const int n0 = nb * 32;
        return CvItem{P.in[opaque_s(I_WEU)] + le * DM * DE, (bf16_t*)(ws + WS_WGU) + le * DM * DM, DM, DE, kb * 64, n0, (n0 >> 7) * 256 + 128 + (n0 & 127)}; }
    r -= CV_I_G;
    CV_KN(r, 32);
    return CvItem{P.in[opaque_s(I_WED)] + le * DE * DM, (bf16_t*)(ws + WS_WD) + le * DM * DE, DE, DM, kb * 64, nb * 32, nb * 32};
}
#undef CV_KN
__device__ __forceinline__ void p0_prologue(Frame& F, const Params& P) {
    {
        LAS float* cact = (LAS float*)F.lds;
        LAS float* red = (LAS float*)(F.lds + 32768);
        const float* c = P.in[I_C];
        bool have = false;
        for (int u = F.vcu; u < NL * 64; u += F.G) {
            if (!have) {
                for (int idx = F.tid; idx < NB * DM; idx += 512) { const int b = idx >> 10, k = idx & 1023; const float v = c[idx]; cact[k * 8 + b] = v / (1.0f + __expf(-v)); }
                have = true; __syncthreads();
            }
            const int l = u >> 6, cb = u & 63, kq = F.tid / 96, cn = F.tid - kq * 96, n = cb * 96 + cn;
            if (kq < 4) {
                const float* w = P.in[I_WMOD] + (size_t)l * DM * NMOD + n;
                float acc[8] = {0.f, 0.f, 0.f, 0.f, 0.f, 0.f, 0.f, 0.f};
#pragma unroll 8
                for (int k = kq * 256; k < kq * 256 + 256; ++k) {
                    const float wv = w[(size_t)k * NMOD];
                    const f32x4 a0 = *(const LAS f32x4*)(cact + k * 8), a1 = *(const LAS f32x4*)(cact + k * 8 + 4);
                    acc[0] += a0[0] * wv; acc[1] += a0[1] * wv; acc[2] += a0[2] * wv; acc[3] += a0[3] * wv;
                    acc[4] += a1[0] * wv; acc[5] += a1[1] * wv; acc[6] += a1[2] * wv; acc[7] += a1[3] * wv;
                }
#pragma unroll
                for (int b = 0; b < 8; ++b) red[(kq * 8 + b) * 96 + cn] = acc[b];
            }
            __syncthreads();
            float* mod = (float*)(F.ws + WS_MOD);
            for (int idx = F.tid; idx < 8 * 96; idx += 512) { const int b = idx / 96, cc = idx - b * 96;
                const float v = red[(0 * 8 + b) * 96 + cc] + red[(1 * 8 + b) * 96 + cc] + red[(2 * 8 + b) * 96 + cc] + red[(3 * 8 + b) * 96 + cc] + P.in[I_BMOD][(size_t)l * NMOD + cb * 96 + cc];
                mod[(size_t)(l * NB + b) * NMOD + cb * 96 + cc] = v; }
            __syncthreads();
        }
        __syncthreads();
    }
    {
        bf16_t* wr = (bf16_t*)(F.ws + WS_WR);
        const int gt = F.vcu * 512 + F.tid, ngt = F.G * 512;
        for (int idx = gt; idx < NL * 64 * DM; idx += ngt) {
            const int k = idx & 1023, n = (idx >> 10) & 63, l = idx >> 16;
            float v = 0.f;
            if (n < NE) v = P.in[I_WRE][((size_t)l * DM + k) * NE + n];
            else if (n < NE + NGRP) v = P.in[I_WRG][((size_t)l * DM + k) * NGRP + (n - NE)];
            wr[idx] = (bf16_t)(cvt_pk_bf16(v, 0.f) & 0xffffu);
        }
    }
    {
        LAS float* scr = (LAS float*)(F.lds + F.wave * 16384);
        const int gw = F.vcu * 8 + F.wave, NGW = F.G * 8;
        auto describe = [&](int c) -> CvItem {
            int it = c;
            if (c >= CV_PER_L) { const int c2 = c - CV_PER_L, l = 1 + c2 / CV_REST; it = l * CV_PER_L + CV_NDELEG + (c2 - (l - 1) * CV_REST); }
            return cv_describe(P, F.ws, it); };
        constexpr int NITEMS = CV_NP0;
        int it = gw;
        if (it < NITEMS) {
            f32x4 va[8], vb[8];
            CvItem da = describe(it), db = da;
            cv_load(da, va, F.lane);
            for (;;) {
                const int it2 = it + NGW; const bool h2 = it2 < NITEMS;
                if (h2) { db = describe(it2); cv_load(db, vb, F.lane); }
                cv_finish(da, va, scr, F.lane);
                if (!h2) break;
                const int it3 = it2 + NGW; const bool h3 = it3 < NITEMS;
                if (h3) { da = describe(it3); cv_load(da, va, F.lane); }
                cv_finish(db, vb, scr, F.lane);
                if (!h3) break;
                it = it3;
            }
        }
    }
}

template <bool ORD>
__device__ __forceinline__ void build_tables(Frame& F, int l) {
    LAS int* tpre = (LAS int*)(F.lds + LC_TPRE); LAS int* cntl = (LAS int*)(F.lds + LC_CNT); LAS int* ord = (LAS int*)(F.lds + LC_ORD);
    if (F.tid < 64) {
        const int e = F.tid & 31;
        const int c = (int)__hip_atomic_load(F.ctl + CW_CNT + l * NE + e, __ATOMIC_RELAXED, __HIP_MEMORY_SCOPE_AGENT);
        const int nt = (c + 255) >> 8, sm = (nt > 0 && c - 256 * (nt - 1) <= 128) ? 1 : 0, nfl = nt - sm;
        int pk = nt | (nfl << 10) | (sm << 20);
        int inc = pk;
        const int ol = opaque_v(F.tid & 63);
#pragma unroll
        for (int d = 1; d < 32; d <<= 1) { const int o = __builtin_amdgcn_ds_bpermute((ol - d) << 2, inc); if (e >= d) inc += o; }
        const int exc = inc - pk, tot = __builtin_amdgcn_readlane(inc, 31);
        const int tp = exc & 1023, fp = (exc >> 10) & 1023, sp = (exc >> 20) & 1023, ttot = tot & 1023, ftot = (tot >> 10) & 1023;
        if (F.tid < NE) {
            cntl[e] = c; tpre[e] = tp;
            if (e == NE - 1) { tpre[NE] = ttot; tpre[NE + 1] = ftot; }
            if (ORD) {
                for (int t = 0; t < nfl; ++t) ord[fp + t] = e | (t << 8);
                if (sm) ord[ftot + sp] = e | ((nt - 1) << 8) | (1 << 20);
            }
        }
    }
    __syncthreads();
}

template <bool FINAL>
__device__ __forceinline__ void phase_norm1(Frame& F, const Params& P, int l) {
    const int gw = F.vcu * 8 + F.wave;
    const int NGW = F.G * 8;
    const float* mod = (const float*)(F.ws + WS_MOD);
    const bool comb = FINAL || l > 0;
    const int lp = FINAL ? NL - 1 : l - 1;
    const LAS int* tpre = (const LAS int*)(F.lds + LC_TPRE);
    const int* tok_e = (const int*)(F.ws + ws_tok(lp < 0 ? 0 : lp)); const int* tok_pos = tok_e + 2 * NT; const float* tok_w = (const float*)(tok_pos + 2 * NT);
    const bf16_t* Y = (const bf16_t*)(F.ws + WS_Y);
    bf16_t* H = (bf16_t*)(F.ws + WS_H);
    bf16_t* X = (bf16_t*)(F.ws + WS_X);
    const float* xin = (!FINAL && l == 0) ? P.in[I_X] : nullptr;
    const int wpb = NGW / NB;
    if (wpb * NB != NGW) return;
    const int b = gw / wpb, w0 = gw % wpb;
    f32x4 mul[4], add[4], gt[4];
#pragma unroll
    for (int j = 0; j < 4; ++j) {
        const int col = 4 * F.lane + 256 * j;
        if (FINAL) { mul[j] = *(const f32x4*)(P.in[I_GF] + col); add[j] = (f32x4){0.f, 0.f, 0.f, 0.f}; }
        else { const f32x4 g = *(const f32x4*)(P.in[I_G1] + (size_t)l * DM + col); const float* mb = mod + (size_t)(l * NB + b) * NMOD;
            const f32x4 sc = *(const f32x4*)(mb + DM + col); mul[j] = g * (sc + 1.0f); add[j] = *(const f32x4*)(mb + col); }
        if (comb) gt[j] = *(const f32x4*)(mod + (size_t)(lp * NB + b) * NMOD + 5 * DM + col); else gt[j] = (f32x4){0.f, 0.f, 0.f, 0.f};
    }
    for (int rr = w0; rr < SEQ; rr += 2 * wpb) {
        const size_t rowA[2] = {(size_t)b * SEQ + rr, (size_t)b * SEQ + rr + wpb};
        f32x4 v[2][4];
#pragma unroll
        for (int q = 0; q < 2; ++q)
#pragma unroll
            for (int j = 0; j < 4; ++j) v[q][j] = ld_x4(xin, X, rowA[q] * DM + 4 * F.lane + 256 * j);
        if (comb) {
            size_t p0[2], p1[2]; float w0f[2], w1f[2];
#pragma unroll
            for (int q = 0; q < 2; ++q) { const size_t row = rowA[q];
                const int e0 = tok_e[row * 2], e1 = tok_e[row * 2 + 1];
                p0[q] = (size_t)tpre[e0] * 256 + tok_pos[row * 2]; p1[q] = (size_t)tpre[e1] * 256 + tok_pos[row * 2 + 1];
                w0f[q] = tok_w[row * 2]; w1f[q] = tok_w[row * 2 + 1]; }
            u32x2 ya[2][4], yc[2][4];
#pragma unroll
            for (int q = 0; q < 2; ++q)
#pragma unroll
                for (int j = 0; j < 4; ++j) { ya[q][j] = *(const u32x2*)(Y + p0[q] * DM + 4 * F.lane + 256 * j); yc[q][j] = *(const u32x2*)(Y + p1[q] * DM + 4 * F.lane + 256 * j); }
#pragma unroll
            for (int q = 0; q < 2; ++q)
#pragma unroll
                for (int j = 0; j < 4; ++j) {
                    const u32x2 a = ya[q][j], c = yc[q][j];
                    f32x4 m;
                    m[0] = w0f[q] * bf_lo(a.x) + w1f[q] * bf_lo(c.x); m[1] = w0f[q] * bf_hi(a.x) + w1f[q] * bf_hi(c.x);
                    m[2] = w0f[q] * bf_lo(a.y) + w1f[q] * bf_lo(c.y); m[3] = w0f[q] * bf_hi(a.y) + w1f[q] * bf_hi(c.y);
                    v[q][j] = v[q][j] + gt[j] * m;
                }
            if (!FINAL) {
#pragma unroll
                for (int q = 0; q < 2; ++q)
#pragma unroll
                    for (int j = 0; j < 4; ++j) st_x4(X, rowA[q] * DM + 4 * F.lane + 256 * j, v[q][j]);
            }
        }
#pragma unroll
        for (int q = 0; q < 2; ++q) {
            const size_t row = rowA[q];
            float ss = 0.f;
#pragma unroll
            for (int j = 0; j < 4; ++j) ss += (v[q][j][0] * v[q][j][0] + v[q][j][1] * v[q][j][1]) + (v[q][j][2] * v[q][j][2] + v[q][j][3] * v[q][j][3]);
            const float rinv = __builtin_amdgcn_rsqf(wave_sum(ss) * (1.0f / DM) + EPS);
            if (FINAL) {
#pragma unroll
                for (int j = 0; j < 4; ++j) *(f32x4*)(P.out + row * DM + 4 * F.lane + 256 * j) = v[q][j] * rinv * mul[j];
            } else {
#pragma unroll
                for (int j = 0; j < 4; ++j) { const f32x4 hv = v[q][j] * rinv * mul[j] + add[j];
                    u32x2 o; o.x = cvt_pk_bf16(hv[0], hv[1]); o.y = cvt_pk_bf16(hv[2], hv[3]);
                    *(u32x2*)(H + row * DM + 4 * F.lane + 256 * j) = o; }
            }
        }
    }
}

__device__ __forceinline__ s16x4 vtr(const LAS unsigned char* p) {
    typedef short v4i16_t __attribute__((ext_vector_type(4)));
    return __builtin_bit_cast(s16x4, __builtin_amdgcn_ds_read_tr16_b64_v4i16((LAS v4i16_t*)p));
}
constexpr int AT_OPITCH = 136;
constexpr int AT_OS = 0, AT_MS = 512 * AT_OPITCH, AT_LS = AT_MS + 2048, AT_VT = AT_LS + 2048;
static_assert(AT_VT + 7 * 8192 <= LDS_SCRATCH && LC_ROWTAB + 8192 <= LDS_BYTES, "attention LDS: waves 0-6 below the control words, wave 7 in the (idle) row-table area");
__device__ __forceinline__ void attn_unit(Frame& F, const bf16_t* QKV, bf16_t* MIX, int b, int h, int c8) {
    const int lane = F.lane, wid = F.wave, r32 = lane & 31, hi = lane >> 5;
    LAS unsigned char* Os = F.lds + AT_OS;
    LAS float* ms = (LAS float*)(F.lds + AT_MS);
    LAS float* ls = (LAS float*)(F.lds + AT_LS);
    LAS unsigned char* Vt = (wid < 7) ? (F.lds + AT_VT + wid * 8192) : (F.lds + LC_ROWTAB);
    LAS unsigned char* Kt = Vt + 4096;
    const LAS unsigned char* krd = Kt + r32 * 128;
    const int t0 = c8 * 512;
    const bf16_t* Qb = QKV + (size_t)b * SEQ * QKVP + h * HD;
    const bf16_t* Kb = Qb + DA; const bf16_t* Vb = Qb + 2 * DA;
    const float sl2 = exp2f(-(float)(h + 1)) * LOG2E;
    const int vq = (lane & 15) >> 2, vp = lane & 3, vg = (lane >> 4) & 1;
    const LAS unsigned char* vrd = Vt + (4 * hi + vq) * 64 + vg * 32 + vp * 8;
#define AT_STAGE_KV(KK, VV) do { _Pragma("unroll") for (int i = 0; i < 4; ++i) { const int id = lane + 64 * i, key = id >> 3, ch = id & 7; \
            *(LAS u32x4*)(Vt + (ch >> 2) * 2048 + key * 64 + (ch & 3) * 16) = VV[i]; \
            *(LAS u32x4*)(Kt + key * 128 + ((ch ^ (key & 7)) << 4)) = KK[i]; } \
        _Pragma("unroll") for (int s_ = 0; s_ < 4; ++s_) kf[s_] = *(const LAS bf16x8*)(krd + (((2 * s_ + hi) ^ (r32 & 7)) << 4)); } while (0)
#define AT_GLOAD_KV(KK, VV, IK0) do { _Pragma("unroll") for (int i = 0; i < 4; ++i) { const int id = lane + 64 * i, key = id >> 3, ch = id & 7; const size_t tv_ = (size_t)(rr + (((IK0) + key) << dsh)); \
            KK[i] = *(const u32x4*)(Kb + tv_ * QKVP + ch * 8); VV[i] = *(const u32x4*)(Vb + tv_ * QKVP + ch * 8); } } while (0)
#pragma unroll 1
    for (int st = 0; st < 3; ++st) {
        const int dsh = 2 * st, dm1 = (1 << dsh) - 1;
        const float sld = sl2 * (float)(1 << dsh);
        if (st < 2) {
            const int rr = (st == 0) ? 0 : (wid & 3);
            const int qiA = (st == 0) ? 2 * wid : 2 * (wid >> 2);
            const int iq0A = (t0 >> dsh) + 32 * qiA;
            const int qlA = rr + ((32 * qiA + r32) << dsh), qlB = rr + ((32 * (qiA + 1) + r32) << dsh);
            bf16x8 qfA[4], qfB[4];
#pragma unroll
            for (int s = 0; s < 4; ++s) { qfA[s] = *(const bf16x8*)(Qb + (size_t)(t0 + qlA) * QKVP + 16 * s + 8 * hi); qfB[s] = *(const bf16x8*)(Qb + (size_t)(t0 + qlB) * QKVP + 16 * s + 8 * hi); }
            float mA, lA, mB, lB; f32x16 oA0, oA1, oB0, oB1;
#define AT_LOAD_STATE(M, L, O0, O1, QL) do { M = ms[QL]; L = (hi == 0) ? ls[QL] : 0.f; \
                _Pragma("unroll") for (int g = 0; g < 4; ++g) { \
                    const u32x2 a_ = *(const LAS u32x2*)(Os + (QL) * AT_OPITCH + (8 * g + 4 * hi) * 2); \
                    const u32x2 c_ = *(const LAS u32x2*)(Os + (QL) * AT_OPITCH + (32 + 8 * g + 4 * hi) * 2); \
                    O0[4 * g] = bf_lo(a_.x); O0[4 * g + 1] = bf_hi(a_.x); O0[4 * g + 2] = bf_lo(a_.y); O0[4 * g + 3] = bf_hi(a_.y); \
                    O1[4 * g] = bf_lo(c_.x); O1[4 * g + 1] = bf_hi(c_.x); O1[4 * g + 2] = bf_lo(c_.y); O1[4 * g + 3] = bf_hi(c_.y); } } while (0)
#define AT_STORE_STATE(M, L, O0, O1, QL) do { const float lt_ = L + __shfl_xor(L, 32); if (hi == 0) { ms[QL] = M; ls[QL] = lt_; } \
                _Pragma("unroll") for (int g = 0; g < 4; ++g) { u32x2 a_, c_; \
                    a_.x = cvt_pk_bf16(O0[4 * g], O0[4 * g + 1]); a_.y = cvt_pk_bf16(O0[4 * g + 2], O0[4 * g + 3]); \
                    c_.x = cvt_pk_bf16(O1[4 * g], O1[4 * g + 1]); c_.y = cvt_pk_bf16(O1[4 * g + 2], O1[4 * g + 3]); \
                    *(LAS u32x2*)(Os + (QL) * AT_OPITCH + (8 * g + 4 * hi) * 2) = a_; \
                    *(LAS u32x2*)(Os + (QL) * AT_OPITCH + (32 + 8 * g + 4 * hi) * 2) = c_; } } while (0)
#define AT_QK(QF, S, CJ, MOLD, MDIAG) do { \
                const float lb_ = (CJ) - sld * (float)(r32 - 4 * hi); \
                _Pragma("unroll") for (int r = 0; r < 16; ++r) S[r] = fmaf(sld, (float)((r & 3) + 8 * (r >> 2)), lb_); \
                _Pragma("unroll") for (int s = 0; s < 4; ++s) S = __builtin_amdgcn_mfma_f32_32x32x16_bf16(kf[s], QF[s], S, 0, 0, 0); \
                if (MOLD) { const int dq_ = opaque_v(r32 - 4 * hi);     \
                    _Pragma("unroll") for (int r = 0; r < 16; ++r) if (((r & 3) + 8 * (r >> 2)) < dq_) S[r] = -1e30f; } \
                if (MDIAG) { const int dq_ = opaque_v(r32 - 4 * hi); \
                    _Pragma("unroll") for (int r = 0; r < 16; ++r) if (((r & 3) + 8 * (r >> 2)) > dq_) S[r] = -1e30f; } } while (0)
#define AT_SMPV(S, M, L, O0, O1) do { \
                float mx = S[0]; \
                _Pragma("unroll") for (int r = 1; r < 16; ++r) mx = fmaxf(mx, S[r]); \
                if (__any(mx > M + 6.0f)) { mx = fmaxf(mx, __shfl_xor(mx, 32)); const float mn = fmaxf(M, mx); const float alpha = fast_exp2(M - mn); M = mn; L *= alpha; \
                    _Pragma("unroll") for (int r = 0; r < 16; ++r) { O0[r] *= alpha; O1[r] *= alpha; } } \
                float ps = 0.f; \
                _Pragma("unroll") for (int r = 0; r < 16; ++r) { S[r] = fast_exp2(S[r] - M); ps += S[r]; } \
                L += ps; \
                u32x4 pw0, pw1; \
                pw0.x = cvt_pk_bf16(S[0], S[1]); pw0.y = cvt_pk_bf16(S[2], S[3]); pw0.z = cvt_pk_bf16(S[4], S[5]); pw0.w = cvt_pk_bf16(S[6], S[7]); \
                pw1.x = cvt_pk_bf16(S[8], S[9]); pw1.y = cvt_pk_bf16(S[10], S[11]); pw1.z = cvt_pk_bf16(S[12], S[13]); pw1.w = cvt_pk_bf16(S[14], S[15]); \
                const bf16x8 pb0 = __builtin_bit_cast(bf16x8, pw0), pb1 = __builtin_bit_cast(bf16x8, pw1); \
                O0 = __builtin_amdgcn_mfma_f32_32x32x16_bf16(vf00, pb0, O0, 0, 0, 0); O0 = __builtin_amdgcn_mfma_f32_32x32x16_bf16(vf01, pb1, O0, 0, 0, 0); \
                O1 = __builtin_amdgcn_mfma_f32_32x32x16_bf16(vf10, pb0, O1, 0, 0, 0); O1 = __builtin_amdgcn_mfma_f32_32x32x16_bf16(vf11, pb1, O1, 0, 0, 0); } while (0)
#define AT_LOADKV(J) AT_GLOAD_KV(kk, vv, iq0A - 128 + 32 * (J))
            if (st == 0) { mA = -1e30f; lA = 0.f; mB = -1e30f; lB = 0.f;
#pragma unroll
                for (int r = 0; r < 16; ++r) { oA0[r] = 0.f; oA1[r] = 0.f; oB0[r] = 0.f; oB1[r] = 0.f; } }
            else { AT_LOAD_STATE(mA, lA, oA0, oA1, qlA); AT_LOAD_STATE(mB, lB, oB0, oB1, qlB); }
            const int jstart = (iq0A >= 128) ? 0 : ((128 - iq0A) >> 5);
#pragma unroll 1
            for (int j = jstart; j < 6; ++j) {
                bf16x8 kf[4];
                { u32x4 kk[4], vv[4]; AT_LOADKV(j); AT_STAGE_KV(kk, vv); }
                const bool actA = (j <= 4), actB = (j >= 1);
                bf16x8 vf00, vf01, vf10, vf11;
                { const s16x4 a0 = vtr(vrd), a1 = vtr(vrd + 512), a2 = vtr(vrd + 1024), a3 = vtr(vrd + 1536);
                  const s16x4 b0 = vtr(vrd + 2048), b1 = vtr(vrd + 2048 + 512), b2 = vtr(vrd + 2048 + 1024), b3 = vtr(vrd + 2048 + 1536);
                  vf00 = (bf16x8){a0[0], a0[1], a0[2], a0[3], a1[0], a1[1], a1[2], a1[3]}; vf01 = (bf16x8){a2[0], a2[1], a2[2], a2[3], a3[0], a3[1], a3[2], a3[3]};
                  vf10 = (bf16x8){b0[0], b0[1], b0[2], b0[3], b1[0], b1[1], b1[2], b1[3]}; vf11 = (bf16x8){b2[0], b2[1], b2[2], b2[3], b3[0], b3[1], b3[2], b3[3]}; }
                if (actA) { f32x16 sA; AT_QK(qfA, sA, -sld * (float)(128 - 32 * j), j == 0, j == 4); AT_SMPV(sA, mA, lA, oA0, oA1); }
                f32x16 sB;
                if (actB) AT_QK(qfB, sB, -sld * (float)(160 - 32 * j), j == 1, j == 5);
                if (actB) AT_SMPV(sB, mB, lB, oB0, oB1);
            }
            AT_STORE_STATE(mA, lA, oA0, oA1, qlA); AT_STORE_STATE(mB, lB, oB0, oB1, qlB);
#undef AT_LOAD_STATE
#undef AT_STORE_STATE
#undef AT_QK
#undef AT_SMPV
#undef AT_LOADKV
        } else {
#pragma unroll 1
        for (int qq = 0; qq < 2; ++qq) {
            const int qt = wid * 2 + qq;
            const int rr = qt & dm1, qi = qt >> dsh;
            const int iq0 = (t0 >> dsh) + 32 * qi;
            const int ql = rr + ((32 * qi + r32) << dsh);
            const int tq = t0 + ql;
            bf16x8 qf[4];
#pragma unroll
            for (int s = 0; s < 4; ++s) qf[s] = *(const bf16x8*)(Qb + (size_t)tq * QKVP + 16 * s + 8 * hi);
            float m, l; f32x16 o0, o1;
            if (st == 0) {
                m = -1e30f; l = 0.f;
#pragma unroll
                for (int r = 0; r < 16; ++r) { o0[r] = 0.f; o1[r] = 0.f; }
            } else {
                m = ms[ql]; l = (hi == 0) ? ls[ql] : 0.f;
#pragma unroll
                for (int g = 0; g < 4; ++g) {
                    const u32x2 a = *(const LAS u32x2*)(Os + ql * AT_OPITCH + (8 * g + 4 * hi) * 2);
                    const u32x2 c = *(const LAS u32x2*)(Os + ql * AT_OPITCH + (32 + 8 * g + 4 * hi) * 2);
                    o0[4 * g] = bf_lo(a.x); o0[4 * g + 1] = bf_hi(a.x); o0[4 * g + 2] = bf_lo(a.y); o0[4 * g + 3] = bf_hi(a.y);
                    o1[4 * g] = bf_lo(c.x); o1[4 * g + 1] = bf_hi(c.x); o1[4 * g + 2] = bf_lo(c.y); o1[4 * g + 3] = bf_hi(c.y);
                }
            }
            const int jmin = (iq0 >= 128) ? 0 : ((128 - iq0) >> 5);
            u32x4 kk[4], vv[4];
            AT_GLOAD_KV(kk, vv, iq0 - 128 + 32 * jmin);
#pragma unroll 1
            for (int j = jmin; j < 5; ++j) {
                bf16x8 kf[4];
                AT_STAGE_KV(kk, vv);
                if (j < 4) AT_GLOAD_KV(kk, vv, iq0 - 128 + 32 * (j + 1));
                const float lb_ = -sld * (float)(128 - 32 * j) - sld * (float)(r32 - 4 * hi);
                f32x16 sacc;
#pragma unroll
                for (int r = 0; r < 16; ++r) sacc[r] = fmaf(sld, (float)((r & 3) + 8 * (r >> 2)), lb_);
#pragma unroll
                for (int s = 0; s < 4; ++s) sacc = __builtin_amdgcn_mfma_f32_32x32x16_bf16(kf[s], qf[s], sacc, 0, 0, 0);
                if (j == 0) { const int dq_ = opaque_v(r32 - 4 * hi);
#pragma unroll
                    for (int r = 0; r < 16; ++r) if (((r & 3) + 8 * (r >> 2)) < dq_) sacc[r] = -1e30f;
                }
                if (j == 4) { const int dq_ = opaque_v(r32 - 4 * hi);
#pragma unroll
                    for (int r = 0; r < 16; ++r) if (((r & 3) + 8 * (r >> 2)) > dq_) sacc[r] = -1e30f;
                }
                float mx = sacc[0];
#pragma unroll
                for (int r = 1; r < 16; ++r) mx = fmaxf(mx, sacc[r]);
                if (__any(mx > m + 6.0f)) {
                    mx = fmaxf(mx, __shfl_xor(mx, 32));
                    const float mn = fmaxf(m, mx);
                    const float alpha = fast_exp2(m - mn);
                    m = mn; l *= alpha;
#pragma unroll
                    for (int r = 0; r < 16; ++r) { o0[r] *= alpha; o1[r] *= alpha; }
                }
                float ps = 0.f;
#pragma unroll
                for (int r = 0; r < 16; ++r) { sacc[r] = fast_exp2(sacc[r] - m); ps += sacc[r]; }
                l += ps;
                u32x4 pw0, pw1;
                pw0.x = cvt_pk_bf16(sacc[0], sacc[1]); pw0.y = cvt_pk_bf16(sacc[2], sacc[3]); pw0.z = cvt_pk_bf16(sacc[4], sacc[5]); pw0.w = cvt_pk_bf16(sacc[6], sacc[7]);
                pw1.x = cvt_pk_bf16(sacc[8], sacc[9]); pw1.y = cvt_pk_bf16(sacc[10], sacc[11]); pw1.z = cvt_pk_bf16(sacc[12], sacc[13]); pw1.w = cvt_pk_bf16(sacc[14], sacc[15]);
                const bf16x8 pb0 = __builtin_bit_cast(bf16x8, pw0), pb1 = __builtin_bit_cast(bf16x8, pw1);
#pragma unroll
                for (int d0 = 0; d0 < 2; ++d0) {
                    const s16x4 a0 = vtr(vrd + d0 * 2048), a1 = vtr(vrd + d0 * 2048 + 512), a2 = vtr(vrd + d0 * 2048 + 1024), a3 = vtr(vrd + d0 * 2048 + 1536);
                    const bf16x8 vf0 = (bf16x8){a0[0], a0[1], a0[2], a0[3], a1[0], a1[1], a1[2], a1[3]};
                    const bf16x8 vf1 = (bf16x8){a2[0], a2[1], a2[2], a2[3], a3[0], a3[1], a3[2], a3[3]};
                    if (d0 == 0) { o0 = __builtin_amdgcn_mfma_f32_32x32x16_bf16(vf0, pb0, o0, 0, 0, 0); o0 = __builtin_amdgcn_mfma_f32_32x32x16_bf16(vf1, pb1, o0, 0, 0, 0); }
                    else { o1 = __builtin_amdgcn_mfma_f32_32x32x16_bf16(vf0, pb0, o1, 0, 0, 0); o1 = __builtin_amdgcn_mfma_f32_32x32x16_bf16(vf1, pb1, o1, 0, 0, 0); }
                }
            }
            const float lt = l + __shfl_xor(l, 32);
            if (st < 2) {
                if (hi == 0) { ms[ql] = m; ls[ql] = lt; }
#pragma unroll
                for (int g = 0; g < 4; ++g) {
                    u32x2 a, c;
                    a.x = cvt_pk_bf16(o0[4 * g], o0[4 * g + 1]); a.y = cvt_pk_bf16(o0[4 * g + 2], o0[4 * g + 3]);
                    c.x = cvt_pk_bf16(o1[4 * g], o1[4 * g + 1]); c.y = cvt_pk_bf16(o1[4 * g + 2], o1[4 * g + 3]);
                    *(LAS u32x2*)(Os + ql * AT_OPITCH + (8 * g + 4 * hi) * 2) = a;
                    *(LAS u32x2*)(Os + ql * AT_OPITCH + (32 + 8 * g + 4 * hi) * 2) = c;
                }
            } else {
                const float li = fast_rcp(lt);
                bf16_t* orow = MIX + ((size_t)b * SEQ + tq) * DM + h * HD;
#pragma unroll
                for (int g = 0; g < 4; ++g) {
                    u32x2 a, c;
                    a.x = cvt_pk_bf16(o0[4 * g] * li, o0[4 * g + 1] * li); a.y = cvt_pk_bf16(o0[4 * g + 2] * li, o0[4 * g + 3] * li);
                    c.x = cvt_pk_bf16(o1[4 * g] * li, o1[4 * g + 1] * li); c.y = cvt_pk_bf16(o1[4 * g + 2] * li, o1[4 * g + 3] * li);
                    *(u32x2*)(orow + 8 * g + 4 * hi) = a;
                    *(u32x2*)(orow + 32 + 8 * g + 4 * hi) = c;
                }
            }
        }
        }
        __syncthreads();
    }
#undef AT_STAGE_KV
#undef AT_GLOAD_KV
}

constexpr int CV_XS = 0, CV_OT = 64512;
static_assert(CV_OT + 32 * DC * 4 <= LDS_SCRATCH && 63 * 1024 <= CV_OT && 7 * 8448 <= 32 * DC * 4 && LC_ROWTAB + 8448 <= LDS_BYTES, "conv LDS");
__device__ __forceinline__ void conv_stage_load(const bf16_t* GLU, int unit, int tid, u32x4 (&v)[8]) {
    const int t0g = unit * 32, tloc = t0g & (SEQ - 1);
#pragma unroll
    for (int i = 0; i < 8; ++i) { const int idx = tid + 512 * i, r = idx >> 6, ch = idx & 63; const int t = tloc - 30 + r;
        v[i] = (u32x4){0u, 0u, 0u, 0u};
        if (t >= 0 && r < 62) v[i] = *(const u32x4*)(GLU + (size_t)(t0g - 30 + r) * DC + ch * 8); }
}
__device__ __forceinline__ void conv_stage_store(LAS unsigned char* xs, int tid, const u32x4 (&v)[8]) {
#pragma unroll
    for (int i = 0; i < 8; ++i) { const int idx = tid + 512 * i, r = idx >> 6, ch = idx & 63;
        if (r < 63) *(LAS u32x4*)(xs + r * 1024 + ch * 16) = v[i]; }
}
__device__ __forceinline__ void conv_stage_load_new(const bf16_t* GLU, int unit, int tid, u32x4 (&v)[4]) {
#pragma unroll
    for (int i = 0; i < 4; ++i) { const int idx = tid + 512 * i; v[i] = *(const u32x4*)(GLU + (size_t)(unit * 32 + (idx >> 6)) * DC + (idx & 63) * 8); }
}
__device__ __forceinline__ void conv_stage_shift_store(LAS unsigned char* xs, int tid, const u32x4 (&v)[4]) {
    u32x4 t[4];
#pragma unroll
    for (int i = 0; i < 4; ++i) { const int idx = tid + 512 * i; if (idx < 30 * 64) t[i] = *(const LAS u32x4*)(xs + (32 + (idx >> 6)) * 1024 + (idx & 63) * 16); }
#pragma unroll
    for (int i = 0; i < 4; ++i) { const int idx = tid + 512 * i; if (idx < 30 * 64) *(LAS u32x4*)(xs + (idx >> 6) * 1024 + (idx & 63) * 16) = t[i]; }
    __syncthreads();
#pragma unroll
    for (int i = 0; i < 4; ++i) { const int idx = tid + 512 * i; *(LAS u32x4*)(xs + (30 + (idx >> 6)) * 1024 + (idx & 63) * 16) = v[i]; }
}
__device__ __forceinline__ void conv_taps(Frame& F, const f32x2 (&wreg)[CW], const f32x2 cb2) {
    const LAS unsigned char* xs = F.lds + CV_XS; LAS unsigned char* ot = F.lds + CV_OT;
    const int cq = F.wave & 3, th = F.wave >> 2, cpair = 128 * cq + 2 * F.lane;
#pragma unroll 1
    for (int g = 0; g < 2; ++g) {
        const int ob = 16 * th + 8 * g;
        unsigned xraw[38];
#pragma unroll
        for (int r = 0; r < 38; ++r) xraw[r] = *(const LAS unsigned*)(xs + (ob + r) * 1024 + cpair * 2);
        f32x2 acc[8];
#pragma unroll
        for (int o = 0; o < 8; ++o) acc[o] = cb2;
        f32x2 xw[8];
#pragma unroll
        for (int o = 0; o < 7; ++o) xw[o] = (f32x2){bf_lo(xraw[o]), bf_hi(xraw[o])};
#pragma unroll
        for (int j = 0; j < CW; ++j) {
            xw[(j + 7) & 7] = (f32x2){bf_lo(xraw[j + 7]), bf_hi(xraw[j + 7])};
#pragma unroll
            for (int o = 0; o < 8; ++o) acc[o] = __builtin_elementwise_fma(wreg[j], xw[(j + o) & 7], acc[o]);
        }
#pragma unroll
        for (int o = 0; o < 8; ++o) *(LAS f32x2*)(ot + (ob + o) * (DC * 4) + cpair * 4) = acc[o];
    }
}
__device__ __forceinline__ void conv_ln_store(Frame& F, bf16_t* MIX, int unit, const f32x4 (&lg)[2], const f32x4 (&lb)[2]) {
    const LAS unsigned char* ot = F.lds + CV_OT;
    const int t0g = unit * 32, o0 = 4 * F.wave, c0 = 8 * F.lane;
#pragma unroll
    for (int o = 0; o < 4; ++o) {
        const f32x4 a0 = *(const LAS f32x4*)(ot + (o0 + o) * (DC * 4) + c0 * 4), a1 = *(const LAS f32x4*)(ot + (o0 + o) * (DC * 4) + c0 * 4 + 16);
        float acc[8] = {a0[0], a0[1], a0[2], a0[3], a1[0], a1[1], a1[2], a1[3]};
        float s1 = 0.f;
#pragma unroll
        for (int c = 0; c < 8; ++c) s1 += acc[c];
        const float mean = wave_sum(s1) * (1.0f / DC);
        float s2 = 0.f;
#pragma unroll
        for (int c = 0; c < 8; ++c) { acc[c] -= mean; s2 += acc[c] * acc[c]; }
        const float rstd = __builtin_amdgcn_rsqf(wave_sum(s2) * (1.0f / DC) + EPS);
        float y[8];
#pragma unroll
        for (int c = 0; c < 4; ++c) { y[c] = acc[c] * rstd * lg[0][c] + lb[0][c]; y[4 + c] = acc[4 + c] * rstd * lg[1][c] + lb[1][c]; }
#pragma unroll
        for (int c = 0; c < 8; ++c) y[c] = y[c] * sigmoidf_fast(y[c]);
        u32x4 w; w.x = cvt_pk_bf16(y[0], y[1]); w.y = cvt_pk_bf16(y[2], y[3]); w.z = cvt_pk_bf16(y[4], y[5]); w.w = cvt_pk_bf16(y[6], y[7]);
        *(u32x4*)(MIX + (size_t)(t0g + o0 + o) * DM + DA + c0) = w;
    }
}
__device__ __forceinline__ void phase_attn(Frame& F) {
    const bf16_t* QKV = (const bf16_t*)(F.ws + WS_QKV); bf16_t* MIX = (bf16_t*)(F.ws + WS_MIX);
    const int nun = NB * NH * 8, per = (nun + F.G - 1) / F.G;
#pragma unroll 1
    for (int k = 0; k < per; ++k) {
        int b, h, c8;
        if (F.G == 256) { const int j = F.vcu & 31; b = F.vcu >> 5; h = 4 * k + (j >> 3); c8 = j & 7; }
        else { const int u = F.vcu + k * F.G; if (u >= nun) break; b = u >> 6; h = (u >> 3) & 7; c8 = u & 7; }
        attn_unit(F, QKV, MIX, b, h, c8);
    }
}
__device__ __forceinline__ void phase_conv(Frame& F, const Params& P, int l) {
    const bf16_t* GLU = (const bf16_t*)(F.ws + WS_GLU); bf16_t* MIX = (bf16_t*)(F.ws + WS_MIX);
    const int nun = NT / 32, upb = (nun + F.G - 1) / F.G, u0 = F.vcu * upb;
    int u1 = u0 + upb; u1 = u1 < nun ? u1 : nun;
    if (u0 >= u1) return;
    u32x4 v[8];
    conv_stage_load(GLU, u0, F.tid, v);
    f32x2 wreg[CW]; f32x2 cb2;
    { const int cpair = 128 * (F.wave & 3) + 2 * F.lane; const float* cw = P.in[I_CONVW] + (size_t)l * CW * DC + cpair;
#pragma unroll
      for (int j = 0; j < CW; ++j) wreg[j] = *(const f32x2*)(cw + (size_t)j * DC);
      cb2 = *(const f32x2*)(P.in[I_CONVB] + (size_t)l * DC + cpair); }
    conv_stage_store(F.lds + CV_XS, F.tid, v);
    __syncthreads();
#pragma unroll 1
    for (int u = u0; u < u1; ++u) {
        const bool more = u + 1 < u1;
        f32x4 cva[CV_PER_UNIT][8];
        u32x4 vn[4];
        if (more) conv_stage_load_new(GLU, u + 1, F.tid, vn);
        if (CONV_CV && CV_PER_UNIT > 1 && l + 1 < NL) {
            const int cr1 = (opaque_s(F.vcu) * 8 + F.wave) + ((u - u0) * CV_PER_UNIT + 1) * (F.G * 8);
            if (cr1 < CV_NCONV) { const CvItem cd = cv_describe(P, F.ws, (l + 1) * CV_PER_L + cr1); cv_load(cd, cva[1], opaque_v(F.lane)); } }
        conv_taps(F, wreg, cb2);
        const int lane2 = opaque_v(F.lane);
        const int NGW = F.G * 8, cr = (opaque_s(F.vcu) * 8 + F.wave) + (u - u0) * CV_PER_UNIT * NGW; const bool cv = CONV_CV && (l + 1 < NL) && cr + (CV_PER_UNIT - 1) * NGW < CV_NCONV;
        if (cv) { const CvItem cd = cv_describe(P, F.ws, (l + 1) * CV_PER_L + opaque_s(cr)); cv_load(cd, cva[0], lane2); }
        f32x4 lg[2], lb[2];
#pragma unroll
        for (int i = 0; i < 2; ++i) { lg[i] = *(const f32x4*)(P.in[I_LNG] + (size_t)l * DC + 8 * lane2 + 4 * i); lb[i] = *(const f32x4*)(P.in[I_LNB] + (size_t)l * DC + 8 * lane2 + 4 * i); }
        __syncthreads();
        if (more) conv_stage_shift_store(F.lds + CV_XS, F.tid, vn);
        conv_ln_store(F, MIX, u, lg, lb);
        __syncthreads();
        if (cv) {
#pragma unroll
            for (int q = 0; q < CV_PER_UNIT; ++q) { const CvItem cd = cv_describe(P, F.ws, (l + 1) * CV_PER_L + opaque_s(cr + q * NGW));
                cv_finish(cd, cva[q], (LAS float*)((F.wave < 7) ? (F.lds + CV_OT + F.wave * 8448) : (F.lds + LC_ROWTAB)), opaque_v(F.lane)); }
            __syncthreads(); }
    }
}

__device__ __forceinline__ void cv_tail_items(Frame& F, const Params& P, int lw) {
    LAS float* scr = (LAS float*)(F.lds + F.wave * 16384);
    unsigned* q = F.ctl + CW_CVQ + lw * 32;
#pragma unroll 1
    for (;;) {
        int i = 0;
        if (F.lane == 0) i = (int)__hip_atomic_fetch_add(q, 2u, __ATOMIC_RELAXED, __HIP_MEMORY_SCOPE_AGENT);
        i = __builtin_amdgcn_readfirstlane(i);
        if (i >= CV_NH) break;
        f32x4 va[8], vb[8];
        const CvItem da = cv_describe(P, F.ws, lw * CV_PER_L + CV_NCONV + i), db = cv_describe(P, F.ws, lw * CV_PER_L + CV_NCONV + i + 1);
        cv_load(da, va, F.lane); cv_load(db, vb, F.lane);
        cv_finish(da, va, scr, F.lane); cv_finish(db, vb, scr, F.lane);
    }
}

constexpr int RT_PITCH = 2064;
constexpr int RT_LW = 40;
constexpr int RT_A = 0, RT_LOG = 32 * RT_PITCH, RT_LCNT = RT_LOG + 8 * 32 * RT_LW * 4, RT_LBASE = RT_LCNT + 128, RT_SEL = RT_LBASE + 128;
static_assert(RT_SEL + 4 * 6 * 32 * 4 <= LDS_SCRATCH, "router LDS");
__device__ __forceinline__ void phase_router(Frame& F, const Params& P, int l, int cslot) {
    const float* mod = (const float*)(F.ws + WS_MOD);
    bf16_t* H = (bf16_t*)(F.ws + ws_h2(l)); const bf16_t* X = (const bf16_t*)(F.ws + WS_X);
    int* tok_e = (int*)(F.ws + ws_tok(l)); int* tok_pos = tok_e + 2 * NT; float* tok_w = (float*)(tok_pos + 2 * NT);
    int* list = (int*)(F.ws + ws_list(l));
    LAS unsigned char* At = F.lds + RT_A; LAS float* logit = (LAS float*)(F.lds + RT_LOG); LAS int* lcnt = (LAS int*)(F.lds + RT_LCNT); LAS int* lbase = (LAS int*)(F.lds + RT_LBASE);
    const int lane = F.lane, w = F.wave, r32 = lane & 31, hi = lane >> 5;
    const bf16_t* wr = (const bf16_t*)(F.ws + WS_WR) + (size_t)l * 64 * DM;
    bf16x8 bfr[8][2];
#pragma unroll
    for (int s = 0; s < 8; ++s)
#pragma unroll
        for (int n2 = 0; n2 < 2; ++n2) bfr[s][n2] = *(const bf16x8*)(wr + (size_t)(32 * n2 + r32) * DM + 128 * w + 16 * s + 8 * hi);
    const int nunits = NT / 32, upb = (nunits + F.G - 1) / F.G;
    int bcur = -1; f32x4 mul[4], add[4];
#pragma unroll 1
    for (int c0 = 0; c0 < upb; c0 += 4) {
        const int ubase = F.vcu * upb + c0;
        int nu = upb - c0; nu = nu < 4 ? nu : 4; if (ubase + nu > nunits) nu = nunits - ubase;
        if (nu <= 0) break;
        if (F.tid < 32) lcnt[F.tid] = 0;
        LAS int* sel = (LAS int*)(F.lds + RT_SEL);
        u32x2 pf[4][4];
#pragma unroll
        for (int q = 0; q < 4; ++q)
#pragma unroll
            for (int j = 0; j < 4; ++j) pf[q][j] = *(const u32x2*)(X + ((size_t)ubase * 32 + 4 * w + q) * DM + 4 * lane + 256 * j);
#pragma unroll 1
        for (int ui = 0; ui < nu; ++ui) {
            {
                const int row0 = (ubase + ui) * 32, b = row0 / SEQ;
                if (b != bcur) { bcur = b;
#pragma unroll
                    for (int j = 0; j < 4; ++j) { const int col = 4 * lane + 256 * j; const f32x4 g = *(const f32x4*)(P.in[I_G2] + (size_t)l * DM + col); const float* mb = mod + (size_t)(l * NB + b) * NMOD;
                        const f32x4 sc = *(const f32x4*)(mb + 4 * DM + col); mul[j] = g * (sc + 1.0f); add[j] = *(const f32x4*)(mb + 3 * DM + col); } }
#pragma unroll
                for (int q = 0; q < 4; ++q) {
                    const int rl = 4 * w + q; const size_t row = (size_t)row0 + rl;
                    f32x4 v[4]; float ss = 0.f;
#pragma unroll
                    for (int j = 0; j < 4; ++j) { v[j] = (f32x4){bf_lo(pf[q][j].x), bf_hi(pf[q][j].x), bf_lo(pf[q][j].y), bf_hi(pf[q][j].y)}; ss += (v[j][0] * v[j][0] + v[j][1] * v[j][1]) + (v[j][2] * v[j][2] + v[j][3] * v[j][3]); }
                    const float rinv = __builtin_amdgcn_rsqf(wave_sum(ss) * (1.0f / DM) + EPS);
#pragma unroll
                    for (int j = 0; j < 4; ++j) { const f32x4 hv = v[j] * rinv * mul[j] + add[j];
                        u32x2 o; o.x = cvt_pk_bf16(hv[0], hv[1]); o.y = cvt_pk_bf16(hv[2], hv[3]);
                        *(u32x2*)(H + row * DM + 4 * lane + 256 * j) = o;
                        *(LAS u32x2*)(At + rl * RT_PITCH + (4 * lane + 256 * j) * 2) = o; }
                }
                if (ui + 1 < nu) {
#pragma unroll
                    for (int q = 0; q < 4; ++q)
#pragma unroll
                        for (int j = 0; j < 4; ++j) pf[q][j] = *(const u32x2*)(X + ((size_t)(row0 + 32) + 4 * w + q) * DM + 4 * lane + 256 * j);
                }
                __syncthreads();
                {
                    f32x16 a0, a1;
#pragma unroll
                    for (int r = 0; r < 16; ++r) { a0[r] = 0.f; a1[r] = 0.f; }
#pragma unroll
                    for (int s = 0; s < 8; ++s) {
                        const bf16x8 af = *(const LAS bf16x8*)(At + r32 * RT_PITCH + (128 * w + 16 * s + 8 * hi) * 2);
                        a0 = __builtin_amdgcn_mfma_f32_32x32x16_bf16(af, bfr[s][0], a0, 0, 0, 0);
                        a1 = __builtin_amdgcn_mfma_f32_32x32x16_bf16(af, bfr[s][1], a1, 0, 0, 0);
                    }
#pragma unroll
                    for (int r = 0; r < 16; ++r) {
                        logit[(w * 32 + crow(r, hi)) * RT_LW + r32] = a0[r];
                        if (r32 < NGRP) logit[(w * 32 + crow(r, hi)) * RT_LW + 32 + r32] = a1[r];
                    }
                }
                __syncthreads();
                if (F.tid < 32) {
                    const LAS float* lr = logit + F.tid * RT_LW;
                    float g[4]; int grp = 0;
#pragma unroll
                    for (int i = 0; i < 4; ++i) { float sacc = 0.f;
#pragma unroll
                        for (int ww = 0; ww < 8; ++ww) sacc += lr[ww * 32 * RT_LW + 32 + i];
                        g[i] = sacc + P.in[I_BRG][l * NGRP + i]; }
                    float gm = g[0];
#pragma unroll
                    for (int i = 1; i < 4; ++i) if (g[i] > gm) { gm = g[i]; grp = i; }
                    float gs = 0.f;
#pragma unroll
                    for (int i = 0; i < 4; ++i) gs += __expf(g[i] - gm);
                    const float pg = 1.0f / gs;
                    float ev[8];
#pragma unroll
                    for (int i = 0; i < 8; ++i) { float sacc = 0.f;
#pragma unroll
                        for (int ww = 0; ww < 8; ++ww) sacc += lr[ww * 32 * RT_LW + grp * 8 + i];
                        ev[i] = sacc + P.in[I_BRE][l * NE + grp * 8 + i]; }
                    int i1 = 0; float v1 = ev[0];
#pragma unroll
                    for (int i = 1; i < 8; ++i) if (ev[i] > v1) { v1 = ev[i]; i1 = i; }
                    int i2 = -1; float v2 = -3.0e38f;
#pragma unroll
                    for (int i = 0; i < 8; ++i) if (i != i1 && ev[i] > v2) { v2 = ev[i]; i2 = i; }
                    const float ex = __expf(v2 - v1);
                    const int e0 = grp * 8 + i1, e1 = grp * 8 + i2;
                    LAS int* sl = sel + ui * 192 + F.tid;
                    sl[0] = e0; sl[32] = e1;
                    sl[64] = __hip_atomic_fetch_add(lcnt + e0, 1, __ATOMIC_RELAXED, __HIP_MEMORY_SCOPE_WORKGROUP);
                    sl[96] = __hip_atomic_fetch_add(lcnt + e1, 1, __ATOMIC_RELAXED, __HIP_MEMORY_SCOPE_WORKGROUP);
                    sl[128] = __float_as_int(pg / (1.0f + ex)); sl[160] = __float_as_int(pg * ex / (1.0f + ex));
                }
            }
        }
        __syncthreads();
        if (F.tid < 32) { const int c = lcnt[F.tid]; lbase[F.tid] = c ? (int)__hip_atomic_fetch_add(F.ctl + CW_CNT + cslot * NE + F.tid, (unsigned)c, __ATOMIC_RELAXED, __HIP_MEMORY_SCOPE_AGENT) : 0; }
        __syncthreads();
        if (F.tid < 32) {
#pragma unroll 1
            for (int ui = 0; ui < nu; ++ui) {
                const LAS int* sl = sel + ui * 192 + F.tid;
                const int tok = (ubase + ui) * 32 + F.tid; const int e0 = sl[0], e1 = sl[32], p0 = lbase[e0] + sl[64], p1 = lbase[e1] + sl[96];
                tok_e[tok * 2] = e0; tok_e[tok * 2 + 1] = e1; tok_pos[tok * 2] = p0; tok_pos[tok * 2 + 1] = p1; tok_w[tok * 2] = __int_as_float(sl[128]); tok_w[tok * 2 + 1] = __int_as_float(sl[160]);
                __hip_atomic_store(list + e0 * LCAP + p0, tok, __ATOMIC_RELAXED, __HIP_MEMORY_SCOPE_AGENT);
                __hip_atomic_store(list + e1 * LCAP + p1, tok, __ATOMIC_RELAXED, __HIP_MEMORY_SCOPE_AGENT);
            }
        }
        __syncthreads();
    }
}

constexpr int NPHASE = 2 + 7 * NL;
__global__ void __launch_bounds__(512, 2) hybrid_fwd(Params P) {
    extern __shared__ __attribute__((aligned(16))) unsigned char lds_raw[];
    Frame F;
    F.lds = (LAS unsigned char*)lds_raw;
    F.tid = threadIdx.x; F.lane = F.tid & 63; F.wave = __builtin_amdgcn_readfirstlane(F.tid >> 6);
    F.G = gridDim.x; { const int bx = blockIdx.x; F.vcu = (F.G % 8 == 0) ? (bx % 8) * (F.G / 8) + bx / 8 : bx; }
    F.ws = P.ws; F.ctl = (unsigned*)(P.ws + WS_CTL);
    if (F.tid < 4) ((LAS unsigned*)(F.lds + LC_BAR))[F.tid] = 0u;
    __syncthreads();
    XcdBarrier bar = xcd_barrier_post(F.ctl + CW_BAR, (volatile LAS unsigned*)(F.lds + LC_BAR));
    const int lo = P.ph_lo, hi = P.ph_hi;
#ifndef PH_ENABLE
#define PH_ENABLE 0x3FF
#endif
#ifndef SPLIT_TAIL
#define SPLIT_TAIL 1
#endif
#ifndef QUAD_SEAM
#define QUAD_SEAM 1
#endif
#define EN(b) ((PH_ENABLE >> (b)) & 1)
#ifndef DUP_MASK
#define DUP_MASK 0
#endif
#define NREP(b) (opaque_s((DUP_MASK >> (b)) & 1) + 1)
#define IN(k) (lo <= (k) && (k) < hi)
#ifdef PROBE_2BAR
#define SEAM(k) do { if (IN(k) && IN((k) + 1)) { xcd_barrier(bar); xcd_barrier(bar); } } while (0)
#else
#define SEAM(k) do { if (IN(k) && IN((k) + 1)) xcd_barrier(bar); } while (0)
#endif
#define FRESH() do { F.tid = opaque_v((int)threadIdx.x); F.lane = F.tid & 63; F.wave = __builtin_amdgcn_readfirstlane(F.tid >> 6); } while (0)
    if (EN(0) && IN(0)) { const int nr = NREP(0);
#pragma unroll 1
        for (int rep = 0; rep < nr; ++rep) { FRESH(); p0_prologue(F, P); } }
    SEAM(0);
    float* mod = (float*)(F.ws + WS_MOD);
#pragma unroll 1
    for (int l = 0; l < NL; ++l) {
        const int pb = 1 + 7 * l;
        if (EN(1) && IN(pb + 0)) { FRESH(); if (l > 0 && !(EN(7) && IN(pb - 1))) build_tables<false>(F, l - 1);
            phase_norm1<false>(F, P, l); }
        SEAM(pb + 0);
        if (EN(2) && IN(pb + 1)) { const int nr = NREP(2);
#pragma unroll 1
          for (int rep = 0; rep < nr; ++rep) { FRESH();
            pg8::DenseOrder S; S.init(NT, DIN, DM, F.G, (int)blockIdx.x, F.ws + WS_WIN + (size_t)l * DIN * DM * 2);
            pg8::EpiIn E{(bf16_t*)(F.ws + WS_QKV), (bf16_t*)(F.ws + WS_GLU)};
            pg8::gemm_phase<pg8::EpiIn, pg8::DenseOrder>(F.lds, S, E, (const char*)(F.ws + WS_H), DM, F.tid);
          } }
        SEAM(pb + 1);
        if (IN(pb + 2)) { const int nr3 = NREP(3), nr9 = NREP(9);
#pragma unroll 1
            for (int rep = 0; rep < nr3; ++rep) { FRESH(); phase_attn(F); }
#pragma unroll 1
            for (int rep = 0; rep < nr9; ++rep) { FRESH(); phase_conv(F, P, l); } }
        SEAM(pb + 2);
        if (EN(4) && IN(pb + 3)) { FRESH();
            pg8::DenseOrder S; S.init(NT, DM, DM, F.G, (int)blockIdx.x, F.ws + WS_WOUT + (size_t)l * DM * DM * 2);
            pg8::EpiResid E{l == 0 ? P.in[I_X] : nullptr, (bf16_t*)(F.ws + WS_X), mod + (size_t)l * NB * NMOD + 2 * DM};
            pg8::gemm_phase<pg8::EpiResid, pg8::DenseOrder>(F.lds, S, E, (const char*)(F.ws + WS_MIX), DM, F.tid);
        }
        SEAM(pb + 3);
        if (EN(5) && IN(pb + 4)) {
            if (NREP(5) > 1) { FRESH(); phase_router(F, P, l, NL + l); __syncthreads(); }
            FRESH(); phase_router(F, P, l, l); }
        SEAM(pb + 4);
        if (EN(6) && IN(pb + 5)) { const int nr = NREP(6);
#pragma unroll 1
          for (int rep = 0; rep < nr; ++rep) { FRESH();
            build_tables<true>(F, l);
            const LAS int* tpre = (const LAS int*)(F.lds + LC_TPRE); const LAS int* cntl = (const LAS int*)(F.lds + LC_CNT); LAS int* rowtab = (LAS int*)(F.lds + LC_ROWTAB);
            pg8::MoeOrder<true> S{tpre, rowtab, 4, F.G, F.vcu, DM, (const char*)(F.ws + WS_WGU + (size_t)l * NE * DM * DM * 2), (size_t)DM * DM * 2, (const LAS int*)(F.lds + LC_ORD), 0, 0, 0, 0, nullptr};
            S.init_order();
            if (SPLIT_TAIL) S.T4 = S.C4;
            int* list = (int*)(F.ws + ws_list(l));
            if (F.tid < 256) {
                int rv[MAXU];
#pragma unroll
                for (int i = 0; i < MAXU; ++i) { pg8::Unit u; rv[i] = -1;
                    if (S.next(i, u)) { const int tl = u.pm - tpre[u.e], cn = cntl[u.e]; int p = tl * 256 + F.tid; p = p < cn ? p : cn - 1;
                        rv[i] = __hip_atomic_load(list + u.e * LCAP + p, __ATOMIC_RELAXED, __HIP_MEMORY_SCOPE_AGENT); } }
#pragma unroll
                for (int i = 0; i < MAXU; ++i) if (rv[i] >= 0) rowtab[i * 256 + F.tid] = rv[i];
            }
            __syncthreads();
            pg8::EpiSwiglu E{(bf16_t*)(F.ws + ws_act(l))};
            pg8::gemm_phase<pg8::EpiSwiglu, pg8::MoeOrder<true>>(F.lds, S, E, (const char*)(F.ws + ws_h2(l)), DM, F.tid);
          } }
        if (IN(pb + 5) && IN(pb + 6)) { if (QUAD_SEAM && SPLIT_TAIL) quad_barrier(F.ctl, F.vcu, (unsigned)l, bar.w0); else xcd_barrier(bar); }
        if (EN(7) && IN(pb + 6)) { const int nr = NREP(7);
#pragma unroll 1
          for (int rep = 0; rep < nr; ++rep) { FRESH();
            if (rep > 0 || !(EN(6) && IN(pb + 5))) build_tables<true>(F, l);
            const LAS int* tpre = (const LAS int*)(F.lds + LC_TPRE);
            if (SPLIT_TAIL) {
                const LAS int* cntl = (const LAS int*)(F.lds + LC_CNT); LAS int* rowtab = (LAS int*)(F.lds + LC_ROWTAB);
                pg8::MoeOrder<true> S2{tpre, rowtab, 4, F.G, F.vcu, DM, (const char*)(F.ws + WS_WGU + (size_t)l * NE * DM * DM * 2), (size_t)DM * DM * 2, (const LAS int*)(F.lds + LC_ORD), 0, 0, 0, 0, nullptr};
                S2.init_order(); S2.nfu = 0;
                pg8::Unit u;
                if (S2.next(0, u)) {
                    const int* list = (const int*)(F.ws + ws_list(l));
                    if (F.tid < 256) { const int tl = u.pm - tpre[u.e], cn = cntl[u.e]; int p = tl * 256 + F.tid; p = p < cn ? p : cn - 1;
                        rowtab[F.tid] = __hip_atomic_load(list + u.e * LCAP + p, __ATOMIC_RELAXED, __HIP_MEMORY_SCOPE_AGENT); }
                    __syncthreads();
                    pg8::EpiSwiglu E2{(bf16_t*)(F.ws + ws_act(l))};
                    pg8::gemm_phase<pg8::EpiSwiglu, pg8::MoeOrder<true>>(F.lds, S2, E2, (const char*)(F.ws + ws_h2(l)), DM, F.tid);
                    if (F.tid == 0) {
                        __builtin_amdgcn_fence(__ATOMIC_RELEASE, "agent");
                        __hip_atomic_fetch_add(F.ctl + CW_FLAG + l * 64 + (S2.tmap >> 2), 1u, __ATOMIC_RELAXED, __HIP_MEMORY_SCOPE_AGENT);
                    }
                }
            }
            pg8::MoeOrder<false> S{tpre, nullptr, 4, F.G, F.vcu, DE, (const char*)(F.ws + WS_WD + (size_t)l * NE * DM * DE * 2), (size_t)DM * DE * 2, (const LAS int*)(F.lds + LC_ORD), 0, 0, 0, 0, nullptr};
            S.init_order();
            if (SPLIT_TAIL) { S.tmap = (S.tmap + F.G / 2) % F.G; S.flags = F.ctl + CW_FLAG + l * 64; }
            pg8::EpiY E{(bf16_t*)(F.ws + WS_Y)};
            pg8::gemm_phase<pg8::EpiY, pg8::MoeOrder<false>>(F.lds, S, E, (const char*)(F.ws + ws_act(l)), DE, F.tid);
            if (CONV_CV && CV_NH > 0 && l + 1 < NL && rep == 0) { FRESH(); cv_tail_items(F, P, l + 1); }
          } }
        SEAM(pb + 6);
    }
    if (EN(8) && IN(NPHASE - 1)) { const int nr = NREP(8);
#pragma unroll 1
        for (int rep = 0; rep < nr; ++rep) { FRESH(); if (rep > 0 || !(EN(7) && IN(NPHASE - 2))) build_tables<false>(F, NL - 1); phase_norm1<true>(F, P, 0); } }
#undef IN
#undef SEAM
}

#ifndef N_LAUNCH_MODE
#define N_LAUNCH_MODE 0
#endif
extern "C" void kernel_launch(void* const* d_in, const int* in_sizes, int n_in, void* d_out, int out_size, void* d_ws, size_t ws_size, hipStream_t stream) {
    static int grid = 0;
    if (grid == 0) {
        if (n_in != 20 || out_size != NT * DM || ws_size < WS_END) { fprintf(stderr, "kernel_launch: unexpected shapes (n_in %d out %d ws %zu)\n", n_in, out_size, ws_size); grid = -1; return; }
        int dev = 0, cus = 0, per_cu = 0;
        if (hipGetDevice(&dev) != hipSuccess || hipDeviceGetAttribute(&cus, hipDeviceAttributeMultiprocessorCount, dev) != hipSuccess) { grid = -1; return; }
        if (hipFuncSetAttribute((const void*)hybrid_fwd, hipFuncAttributeMaxDynamicSharedMemorySize, LDS_BYTES) != hipSuccess) { fprintf(stderr, "kernel_launch: hipFuncSetAttribute failed\n"); grid = -1; return; }
        if (hipOccupancyMaxActiveBlocksPerMultiprocessor(&per_cu, (const void*)hybrid_fwd, 512, LDS_BYTES) != hipSuccess || per_cu < 1)
            fprintf(stderr, "kernel_launch: occupancy query reports %d\n", per_cu);
        (void)hipGetLastError();
        grid = cus;
        if (grid > 256) grid = 256;
    }
    if (grid < 0) return;
    (void)hipMemsetAsync((char*)d_ws + WS_CTL, 0, CTL_BYTES, stream);
    Params p{};
    for (int i = 0; i < 20; ++i) p.in[i] = (const float*)d_in[i];
    p.out = (float*)d_out; p.ws = (unsigned char*)d_ws;
#if N_LAUNCH_MODE == 0
    p.ph_lo = 0; p.ph_hi = NPHASE;
    hipLaunchKernelGGL(hybrid_fwd, dim3(grid), dim3(512), LDS_BYTES, stream, p);
#else
#ifndef STOP_AFTER
#define STOP_AFTER NPHASE
#endif
    const int k_first = 0;
    for (int k = k_first; k < STOP_AFTER; ++k) { p.ph_lo = k; p.ph_hi = k + 1; hipLaunchKernelGGL(hybrid_fwd, dim3(grid), dim3(512), LDS_BYTES, stream, p); }
#endif
}
```

```cpp
#include <hip/hip_runtime.h>
#include <cstdio>
#include <cstdint>

#define LAS __attribute__((address_space(3)))
#define GAS __attribute__((address_space(1)))
typedef unsigned short bf16_t;
typedef short bf16x8 __attribute__((ext_vector_type(8)));
typedef short s16x4 __attribute__((ext_vector_type(4)));
typedef float f32x2 __attribute__((ext_vector_type(2)));
typedef float f32x4 __attribute__((ext_vector_type(4)));
typedef float f32x16 __attribute__((ext_vector_type(16)));
typedef unsigned u32x2 __attribute__((ext_vector_type(2)));
typedef unsigned u32x4 __attribute__((ext_vector_type(4)));

constexpr int NB = 8, SEQ = 4096, DM = 1024, NT = NB * SEQ, NL = 4;
constexpr int NH = 8, HD = 64, DA = 512, DC = 512, DIN = 2560, CW = 31;
constexpr int NE = 32, EPG = 8, NGRP = 4, DE = 512, NMOD = 6 * DM;
constexpr int QKVP = 3 * DA;
constexpr int PMAX = 2 * NT + NE * 256;
constexpr int LCAP = NT;
constexpr float EPS = 1e-6f;
constexpr float LOG2E = 1.4426950408889634f;
constexpr float QSCALE = 0.125f * LOG2E;

constexpr size_t MiB = 1u << 20;
constexpr size_t WS_CTL = 0, CTL_BYTES = 96 * 1024;
constexpr size_t WS_MOD = 1 * MiB;
constexpr size_t WS_WR = 2 * MiB;
constexpr size_t WS_TOK = 3 * MiB;
constexpr size_t WS_LIST = 4 * MiB;
constexpr size_t WS_WIN = 8 * MiB;
constexpr size_t WS_WOUT = 28 * MiB;
constexpr size_t WS_WGU = 36 * MiB;
constexpr size_t WS_WD = 292 * MiB;
constexpr size_t WS_H = 420 * MiB;
constexpr size_t WS_ACT = 484 * MiB;
constexpr size_t WS_QKV = 556 * MiB;
constexpr size_t WS_GLU = 652 * MiB;
constexpr size_t WS_MIX = 684 * MiB;
constexpr size_t WS_Y = 556 * MiB;
constexpr size_t WS_X = 748 * MiB;
constexpr size_t WS_H2 = 420 * MiB;
constexpr size_t WS_HP = 876 * MiB;
constexpr size_t WS_ACT1 = WS_ACT, WS_LIST1 = WS_LIST, WS_TOK1 = WS_TOK;
constexpr size_t WS_END = 1020 * MiB;
__device__ __forceinline__ size_t ws_h2(int) { return WS_H2; }
__device__ __forceinline__ size_t ws_act(int l) { return (l & 1) ? WS_ACT1 : WS_ACT; }
__device__ __forceinline__ size_t ws_list(int l) { return (l & 1) ? WS_LIST1 : WS_LIST; }
__device__ __forceinline__ size_t ws_tok(int l) { return (l & 1) ? WS_TOK1 : WS_TOK; }
static_assert(WS_Y + (size_t)PMAX * DM * 2 <= WS_END && WS_ACT + (size_t)PMAX * DE * 2 <= WS_QKV, "ws map");
constexpr int CW_BAR = 4096;
constexpr int CW_CNT = 16384;
constexpr int CW_QBAR = 22528;
constexpr int CW_FLAG = 20480;

constexpr int LDS_SCRATCH = 131072;
constexpr int LC_BAR = LDS_SCRATCH;
constexpr int LC_TPRE = LDS_SCRATCH + 64;
constexpr int LC_CNT = LDS_SCRATCH + 256;
constexpr int LC_ROWTAB = LDS_SCRATCH + 1024;
constexpr int MAXU = 6;
constexpr int LC_ORD = LC_ROWTAB + MAXU * 1024;
constexpr int LDS_BYTES = 147456;

__device__ __forceinline__ unsigned cvt_pk_bf16(float lo, float hi) {
    typedef __bf16 b2 __attribute__((ext_vector_type(2)));
    f32x2 v = {lo, hi}; b2 b = __builtin_convertvector(v, b2); return __builtin_bit_cast(unsigned, b);
}
__device__ __forceinline__ float bf_lo(unsigned u) { return __uint_as_float(u << 16); }
__device__ __forceinline__ float bf_hi(unsigned u) { return __uint_as_float(u & 0xffff0000u); }
__device__ __forceinline__ float wave_sum(float v) {
#pragma unroll
    for (int o = 1; o < 64; o <<= 1) v += __shfl_xor(v, o);
    return v;
}
__device__ __forceinline__ float fast_exp2(float x) { return __builtin_amdgcn_exp2f(x); }
__device__ __forceinline__ float fast_rcp(float x) { return __builtin_amdgcn_rcpf(x); }
__device__ __forceinline__ float sigmoidf_fast(float x) { return fast_rcp(1.0f + fast_exp2(-x * LOG2E)); }
__device__ __forceinline__ int opaque_s(int x) { asm volatile("" : "+s"(x)); return x; }
__device__ __forceinline__ int opaque_v(int x) { asm volatile("" : "+v"(x)); return x; }
__device__ __forceinline__ int crow(int r, int hi) { return (r & 3) + 8 * (r >> 2) + 4 * hi; }

__device__ __forceinline__ f32x4 ld_x4(const float* xf, const bf16_t* xb, size_t idx) {
    if (xf) return *(const f32x4*)(xf + idx);
    const u32x2 u = *(const u32x2*)(xb + idx);
    return (f32x4){bf_lo(u.x), bf_hi(u.x), bf_lo(u.y), bf_hi(u.y)};
}
__device__ __forceinline__ void st_x4(bf16_t* xb, size_t idx, f32x4 v) { u32x2 o; o.x = cvt_pk_bf16(v[0], v[1]); o.y = cvt_pk_bf16(v[2], v[3]); *(u32x2*)(xb + idx) = o; }
#define XB_TMO      128
#define XB_XCNT(j)  (256  + 64 * (j))
#define XB_XSUB(j)  (1280 + 64 * (j))
#define XB_XGEN(j)  (2304 + 64 * (j))
#define XB_TOP      3328
#define XB_TOPGEN   3392
#define XCD_BAR_WORDS 3456
#define XB_SPIN_CAP (1u << 18)
__device__ __forceinline__ unsigned xb_ld(unsigned* p)              { return __hip_atomic_load(p, __ATOMIC_RELAXED, __HIP_MEMORY_SCOPE_AGENT); }
__device__ __forceinline__ unsigned xb_add(unsigned* p, unsigned v) { return __hip_atomic_fetch_add(p, v, __ATOMIC_RELAXED, __HIP_MEMORY_SCOPE_AGENT); }
__device__ __forceinline__ unsigned xb_xcc_id() { return (unsigned)__builtin_amdgcn_s_getreg((3 << 11) | 20) & 0xFu; }
#define XB_SPIN(cond, bar) do { unsigned _sp = 0; while (cond) { __builtin_amdgcn_s_sleep(1); \
    if ((++_sp & 255u) == 0u) { if (xb_ld(&(bar)[XB_TMO])) break; if (_sp > XB_SPIN_CAP) { atomicAdd(&(bar)[XB_TMO], 1u); break; } } } } while (0)
__device__ __forceinline__ bool is_thread0(int w0) { return w0 == 0 && __builtin_amdgcn_mbcnt_hi(~0u, __builtin_amdgcn_mbcnt_lo(~0u, 0u)) == 0u; }
struct XcdBarrier { unsigned* bar; unsigned x; volatile LAS unsigned* st; int w0; };
__device__ __forceinline__ XcdBarrier xcd_barrier_post(unsigned* bar, volatile LAS unsigned* st) {
    XcdBarrier b; b.bar = bar; b.x = xb_xcc_id(); b.st = st; b.w0 = __builtin_amdgcn_readfirstlane((int)(threadIdx.x >> 6));
    if (threadIdx.x == 0) (void)xb_add(&bar[XB_XCNT(b.x)], 1u);
    return b;
}
__device__ __forceinline__ void xcd_barrier_complete(unsigned* bar, unsigned x, unsigned& nloc, unsigned& nx) {
    const unsigned G = gridDim.x * gridDim.y * gridDim.z;
    unsigned sum, cnt, mine, sp = 0u;
    for (;;) {
        sum = 0u; cnt = 0u; mine = 0u;
#pragma unroll
        for (unsigned j = 0; j < 16; ++j) { const unsigned c = xb_ld(&bar[XB_XCNT(j)]); sum += c; cnt += (c > 0u) ? 1u : 0u; mine = (j == x) ? c : mine; }
        if (sum == G) break;
        __builtin_amdgcn_s_sleep(1);
        if ((++sp & 255u) == 0u) { if (xb_ld(&bar[XB_TMO])) break; if (sp > XB_SPIN_CAP) { atomicAdd(&bar[XB_TMO], 1u); break; } }
    }
    nloc = mine > 0u ? mine : 1u; nx = cnt > 0u ? cnt : 1u;
}
__device__ __forceinline__ void xcd_barrier(const XcdBarrier& b) {
    asm volatile("s_waitcnt vmcnt(0)" ::: "memory");
    __syncthreads();
    if (threadIdx.x == 0) {
        unsigned* bar = b.bar;
        __builtin_amdgcn_s_waitcnt(0);
        unsigned nloc = b.st[0], nx = b.st[1];
        if (nloc == 0u) { xcd_barrier_complete(bar, b.x, nloc, nx); b.st[0] = nloc; b.st[1] = nx; }
        const unsigned old = xb_add(&bar[XB_XSUB(b.x)], 1u);
        const unsigned gen = old / nloc;
        if (old + 1u == (gen + 1u) * nloc) {
            __builtin_amdgcn_fence(__ATOMIC_RELEASE, "agent");
            asm volatile("s_waitcnt vmcnt(0)" ::: "memory");
            const unsigned og = xb_add(&bar[XB_TOP], 1u);
            const unsigned tg = og / nx;
            if (og + 1u == (tg + 1u) * nx) xb_add(&bar[XB_TOPGEN], 1u);
            else XB_SPIN(xb_ld(&bar[XB_TOPGEN]) == tg, bar);
            __builtin_amdgcn_fence(__ATOMIC_ACQUIRE, "agent");
            xb_add(&bar[XB_XGEN(b.x)], 1u);
            asm volatile("s_waitcnt vmcnt(0)" ::: "memory");
        } else {
            XB_SPIN(xb_ld(&bar[XB_XGEN(b.x)]) == gen, bar);
            __builtin_amdgcn_fence(__ATOMIC_ACQUIRE, "agent");
            asm volatile("s_waitcnt vmcnt(0)" ::: "memory");
        }
    }
    __syncthreads();
}

__device__ __forceinline__ void quad_barrier(unsigned* ctl, int vcu, unsigned gen, int w0) {
    asm volatile("s_waitcnt vmcnt(0)" ::: "memory");
    __syncthreads();
    if (threadIdx.x == 0) {
        const bool q4 = (gridDim.x & 3u) == 0u;
        unsigned* c = ctl + CW_QBAR + (unsigned)opaque_s(q4 ? (vcu >> 2) * 32 : 0); const unsigned n = q4 ? 4u : gridDim.x;
        __builtin_amdgcn_fence(__ATOMIC_RELEASE, "agent");
        (void)__hip_atomic_fetch_add(c, 1u, __ATOMIC_RELAXED, __HIP_MEMORY_SCOPE_AGENT);
        const unsigned target = (gen + 1u) * n;
        unsigned sp = 0u;
        while (__hip_atomic_load(c, __ATOMIC_RELAXED, __HIP_MEMORY_SCOPE_AGENT) < target) { __builtin_amdgcn_s_sleep(1); if (++sp > (1u << 22)) break; }
        __builtin_amdgcn_fence(__ATOMIC_ACQUIRE, "agent");
        asm volatile("s_waitcnt vmcnt(0)" ::: "memory");
    }
    __syncthreads();
}
namespace pg8 {
constexpr int BM = 256, BK = 64, HALF = 128, HTB = HALF * BK * 2, STAGE_BYTES = 8 * HTB, NXCD = 8, WGM = 8;
__host__ __device__ __forceinline__ int lds_byte(int r, int c) { const int st = (r >> 4) * 2 + (c >> 5), rr = r & 15, cc = c & 31, ob = rr * 64 + cc * 2; return st * 1024 + (ob ^ (((ob >> 9) & 1) << 5)); }
__host__ __device__ __forceinline__ void stage_rc(int b, int& R, int& C) { const int st = b / 1024, sb = b % 1024, swz = sb ^ (((sb >> 9) & 1) << 5); R = (st >> 1) * 16 + swz / 64; C = (st & 1) * 32 + (swz % 64) / 2; }
__host__ __device__ __forceinline__ int perm32(int rho) { const int n = rho >> 4, i = rho & 15; return 8 * (i >> 2) + 4 * n + (i & 3); }
struct Unit { int pm, pn, e, half; };

template <class Epi, class Sched>
__device__ __forceinline__ void gemm_phase(LAS unsigned char* lds, const Sched& S, const Epi& E, const char* Amat, const int K, const int tid_) {
    const int tid = tid_, wid = __builtin_amdgcn_readfirstlane(tid >> 6), lane = tid & 63, wr = wid >> 2, wc = wid & 3, fr = lane & 15, fq = lane >> 4;
    const int nt = K / BK;
    constexpr bool GATHER = Sched::GATHER;
    int Rr[2]; unsigned voffA[2], voffB[2];
#pragma unroll
    for (int i = 0; i < 2; ++i) { int R, C; stage_rc(tid * 16 + i * 8192, R, C); const int Rb = Epi::PERM ? ((R & ~31) + perm32(R & 31)) : R;
        Rr[i] = R; voffA[i] = GATHER ? (unsigned)C * 2u : (unsigned)(R * K + C) * 2u; voffB[i] = (unsigned)(Rb * K + C) * 2u; }
    const size_t kstep = (size_t)(BK * 2);
    const size_t hstepB = (size_t)HALF * K * 2;
    const unsigned rowbytes = (unsigned)(K * 2);
    const unsigned ldsw = (unsigned)wid * 1024u;
    const int aoff = lds_byte(wr * 64 + fr, fq * 8), boff = lds_byte(wc * 32 + fr, fq * 8);
#define PG8_SA(b, h) (((b) * 2 + (h)) * HTB)
#define PG8_SB(b, h) ((4 + (b) * 2 + (h)) * HTB)
#define PG8_STAGE_B(bufoff, gbase) do { _Pragma("unroll") for (int _i = 0; _i < 2; ++_i) \
        __builtin_amdgcn_global_load_lds((const unsigned*)((const char*)(gbase) + voffB[_i]), (LAS unsigned*)(lds + (bufoff) + ldsw + _i * 8192), 16, 0, 0); } while (0)
#define PG8_STAGE_A(bufoff, kb, us, ub, h) do { \
        if constexpr (GATHER) { \
            const unsigned _t0 = (unsigned)S.rowtab[(us) * 256 + (h) * HALF + Rr[0]], _t1 = (unsigned)S.rowtab[(us) * 256 + (h) * HALF + Rr[1]]; \
            __builtin_amdgcn_global_load_lds((const unsigned*)(Amat + (kb) + (_t0 * rowbytes + voffA[0])), (LAS unsigned*)(lds + (bufoff) + ldsw), 16, 0, 0); \
            __builtin_amdgcn_global_load_lds((const unsigned*)(Amat + (kb) + (_t1 * rowbytes + voffA[1])), (LAS unsigned*)(lds + (bufoff) + ldsw + 8192), 16, 0, 0); \
        } else { \
            const char* _b = Amat + (ub) + (size_t)(h) * hstepB + (kb); \
            __builtin_amdgcn_global_load_lds((const unsigned*)(_b + voffA[0]), (LAS unsigned*)(lds + (bufoff) + ldsw), 16, 0, 0); \
            __builtin_amdgcn_global_load_lds((const unsigned*)(_b + voffA[1]), (LAS unsigned*)(lds + (bufoff) + ldsw + 8192), 16, 0, 0); } } while (0)
#define PG8_LDA(dst, b, h) do { _Pragma("unroll") for (int m = 0; m < 4; ++m) _Pragma("unroll") for (int k = 0; k < 2; ++k) dst[m][k] = *(const LAS bf16x8*)(lds + PG8_SA(b, h) + aoff + m * 2048 + k * 1024); } while (0)
#define PG8_LDB(dst, b, h) do { _Pragma("unroll") for (int n = 0; n < 2; ++n) _Pragma("unroll") for (int k = 0; k < 2; ++k) dst[n][k] = *(const LAS bf16x8*)(lds + PG8_SB(b, h) + boff + n * 2048 + k * 1024); } while (0)
#define PG8_MMA(ai, bj, At, Bt) do { __builtin_amdgcn_s_setprio(1); _Pragma("unroll") for (int m = 0; m < 4; ++m) _Pragma("unroll") for (int n = 0; n < 2; ++n) _Pragma("unroll") for (int k = 0; k < 2; ++k) \
        acc[ai][bj][m][n] = __builtin_amdgcn_mfma_f32_16x16x32_bf16(Bt[n][k], At[m][k], acc[ai][bj][m][n], 0, 0, 0); __builtin_amdgcn_s_setprio(0); } while (0)
#define PG8_WAIT_V(n) asm volatile("s_waitcnt vmcnt(" #n ")" ::: "memory")
#define PG8_WAIT_L(n) asm volatile("s_waitcnt lgkmcnt(" #n ")" ::: "memory")
#define PG8_BAR __builtin_amdgcn_s_barrier()
#define PG8_SCHED __builtin_amdgcn_sched_barrier(0)
    Unit cur, nxt; int ui = 0;
    if (!S.next(0, cur)) return;
    f32x4 acc[2][2][4][2];
#pragma unroll
    for (int a = 0; a < 2; ++a)
#pragma unroll
        for (int b = 0; b < 2; ++b)
#pragma unroll
            for (int m = 0; m < 4; ++m)
#pragma unroll
                for (int n = 0; n < 2; ++n) acc[a][b][m][n] = (f32x4){0.f, 0.f, 0.f, 0.f};
    bf16x8 At[4][2], B0[2][2], B1[2][2];
    size_t cU = S.a_ubase(cur);
    const char* cB = S.b_base(cur);
    PG8_STAGE_B(PG8_SB(0, 0), cB); PG8_STAGE_B(PG8_SB(0, 1), cB + hstepB); PG8_STAGE_A(PG8_SA(0, 0), 0, 0, cU, 0); PG8_STAGE_A(PG8_SA(0, 1), 0, 0, cU, 1);
    if (wr == 1) PG8_BAR;
    PG8_WAIT_V(2); PG8_BAR;
    PG8_STAGE_B(PG8_SB(1, 0), cB + kstep); PG8_STAGE_A(PG8_SA(1, 0), kstep, 0, cU, 0); PG8_STAGE_B(PG8_SB(1, 1), cB + hstepB + kstep);
    PG8_WAIT_V(6); PG8_BAR;
    for (;;) {
        const bool has_next = S.next(ui + 1, nxt);
        const char* nB = cB; size_t nU = cU; int nS = ui;
        if (has_next) { nB = S.b_base(nxt); nU = S.a_ubase(nxt); nS = ui + 1; }
        const bool fullu = !Sched::HALFABLE || !cur.half;
        for (int t = 0; t < nt; t += 2) {
            const bool last = (t == nt - 2);
            const size_t k1 = (size_t)(t + 1) * kstep;
            const size_t k2 = last ? (size_t)0 : (size_t)(t + 2) * kstep;
            const size_t k3 = k2 + kstep;
            const char* b2 = last ? nB : cB + (size_t)(t + 2) * kstep; const char* b3 = b2 + kstep;
            const size_t u2 = last ? nU : cU; const int s2 = last ? nS : ui;
            PG8_LDB(B0, 0, 0); PG8_LDB(B1, 0, 1); PG8_SCHED; PG8_LDA(At, 0, 0); PG8_STAGE_A(PG8_SA(1, 1), k1, ui, cU, 1);
            PG8_WAIT_V(8); PG8_WAIT_L(0); PG8_BAR; PG8_MMA(0, 0, At, B0); PG8_MMA(0, 1, At, B1); PG8_BAR; PG8_SCHED;
            if (fullu) PG8_LDA(At, 0, 1); PG8_STAGE_B(PG8_SB(0, 0), b2); PG8_STAGE_B(PG8_SB(0, 1), b2 + hstepB); PG8_STAGE_A(PG8_SA(0, 0), k2, s2, u2, 0);
            PG8_WAIT_V(8); PG8_WAIT_L(0); PG8_BAR; if (fullu) { PG8_MMA(1, 0, At, B0); PG8_MMA(1, 1, At, B1); } PG8_BAR; PG8_SCHED;
            PG8_LDB(B0, 1, 0); PG8_LDB(B1, 1, 1); PG8_SCHED; PG8_LDA(At, 1, 0); PG8_STAGE_A(PG8_SA(0, 1), k2, s2, u2, 1);
            PG8_WAIT_V(8); PG8_WAIT_L(0); PG8_BAR; PG8_MMA(0, 0, At, B0); PG8_MMA(0, 1, At, B1); PG8_BAR; PG8_SCHED;
            if (fullu) PG8_LDA(At, 1, 1); PG8_STAGE_B(PG8_SB(1, 0), b3); PG8_STAGE_B(PG8_SB(1, 1), b3 + hstepB); PG8_STAGE_A(PG8_SA(1, 0), k3, s2, u2, 0);
            PG8_WAIT_V(8); PG8_WAIT_L(0); PG8_BAR; if (fullu) { PG8_MMA(1, 0, At, B0); PG8_MMA(1, 1, At, B1); } PG8_BAR; PG8_SCHED;
        }
        if (wr == 0) PG8_BAR;
        E(acc, cur, wr, wc, fr, fq);
        if (!has_next) break;
#pragma unroll
        for (int a = 0; a < 2; ++a)
#pragma unroll
            for (int b = 0; b < 2; ++b)
#pragma unroll
                for (int m = 0; m < 4; ++m)
#pragma unroll
                    for (int n = 0; n < 2; ++n) acc[a][b][m][n] = (f32x4){0.f, 0.f, 0.f, 0.f};
        cur = nxt; cB = nB; cU = nU; ++ui;
        if (wr == 1) PG8_BAR;
    }
    PG8_WAIT_V(0);
    PG8_BAR;
#undef PG8_SA
#undef PG8_SB
#undef PG8_STAGE_A
#undef PG8_STAGE_B
#undef PG8_LDA
#undef PG8_LDB
#undef PG8_MMA
#undef PG8_WAIT_V
#undef PG8_WAIT_L
#undef PG8_BAR
#undef PG8_SCHED
}

struct DenseOrder {
    int nM, nN, nwg, G, c, K; const char* Bt;
    __device__ void init(int M, int N, int K_, int G_, int c_, const void* Bt_) { rowtab = nullptr; nM = M / BM; nN = N / BM; nwg = nM * nN; G = G_; c = c_; K = K_; Bt = (const char*)Bt_; }
    __device__ __forceinline__ bool next(int i, Unit& u) const {
        const long L = (long)i * G + c; if (L >= nwg) return false;
        int wgid = (int)L; { const int q = nwg / NXCD, r = nwg % NXCD, xcd = wgid % NXCD, off = wgid / NXCD; wgid = (xcd < r ? xcd * (q + 1) : r * (q + 1) + (xcd - r) * q) + off; }
        const int nig = WGM * nN, gid = wgid / nig, fm = gid * WGM, gsz = (nM - fm) < WGM ? (nM - fm) : WGM;
        u.pm = fm + ((wgid % nig) % gsz); u.pn = (wgid % nig) / gsz; u.e = 0; u.half = 0; return true;
    }
    static constexpr bool GATHER = false, HALFABLE = false; const LAS int* rowtab;
    __device__ __forceinline__ size_t a_ubase(const Unit& u) const { return (size_t)u.pm * BM * K * 2; }
    __device__ __forceinline__ const char* b_base(const Unit& u) const { return Bt + (size_t)u.pn * BM * K * 2; }
};
template <bool GATHER_>
struct MoeOrder {
    static constexpr bool GATHER = GATHER_, HALFABLE = true;
    const LAS int* tpre; const LAS int* rowtab; int nN, G, vcu, K; const char* Bt; size_t estride;
    const LAS int* ord; int nfu, tmap, C4, T4;
    const unsigned* flags;
    __device__ __forceinline__ void init_order() {
        const int F4 = tpre[NE + 1] * nN; T4 = tpre[NE] * nN;
        const int rem = F4 % G; C4 = (2 * rem >= G) ? F4 : F4 - rem;
        nfu = vcu < C4 ? (C4 - 1 - vcu) / G + 1 : 0;
        tmap = (G % 8 == 0) ? (vcu % (G / 8)) * 8 + vcu / (G / 8) : vcu;
    }
    __device__ __forceinline__ bool next(int i, Unit& u) const {
        int U;
        if (i < nfu) U = i * G + vcu; else { U = C4 + (i - nfu) * G + tmap; if (U >= T4) return false;
            if (flags) {
                const unsigned* f = flags + (U - C4) / nN;
#pragma unroll 1
                for (int sp = 0; sp < (1 << 20); ++sp) { if (__hip_atomic_load(f, __ATOMIC_RELAXED, __HIP_MEMORY_SCOPE_AGENT) >= (unsigned)nN) break; __builtin_amdgcn_s_sleep(2); }
                __builtin_amdgcn_fence(__ATOMIC_ACQUIRE, "agent");
            } }
        const int g = U / nN; u.pn = U - g * nN;
        const int o = ord[g], e = o & 255;
        u.e = e; u.pm = tpre[e] + ((o >> 8) & 4095); u.half = o >> 20; return true;
    }
    __device__ __forceinline__ size_t a_ubase(const Unit& u) const { return (size_t)u.pm * BM * K * 2; }
    __device__ __forceinline__ const char* b_base(const Unit& u) const { return Bt + (size_t)u.e * estride + (size_t)u.pn * BM * K * 2; }
};

struct EpiIn {
    static constexpr bool PERM = true;
    bf16_t* QKV; bf16_t* GLU;
    __device__ __forceinline__ void operator()(const f32x4 (&acc)[2][2][4][2], const Unit& u, int wr, int wc, int fr, int fq) const {
        const int row0 = u.pm * BM + wr * 64 + fr;
        if (u.pn < 6) {
            const float sc = (u.pn < 2) ? QSCALE : 1.0f;
            const int col0 = u.pn * BM + wc * 32 + 8 * fq;
#pragma unroll
            for (int ai = 0; ai < 2; ++ai)
#pragma unroll
                for (int m = 0; m < 4; ++m) { bf16_t* rowp = QKV + (size_t)(row0 + ai * HALF + m * 16) * QKVP + col0;
#pragma unroll
                    for (int bj = 0; bj < 2; ++bj) { const f32x4 v0 = acc[ai][bj][m][0] * sc, v1 = acc[ai][bj][m][1] * sc;
                        u32x4 w; w.x = cvt_pk_bf16(v0[0], v0[1]); w.y = cvt_pk_bf16(v0[2], v0[3]); w.z = cvt_pk_bf16(v1[0], v1[1]); w.w = cvt_pk_bf16(v1[2], v1[3]);
                        *(u32x4*)(rowp + bj * HALF) = w; } }
        } else {
            const int col0 = (u.pn - 6) * HALF + wc * 32 + 8 * fq;
#pragma unroll
            for (int ai = 0; ai < 2; ++ai)
#pragma unroll
                for (int m = 0; m < 4; ++m) { bf16_t* rowp = GLU + (size_t)(row0 + ai * HALF + m * 16) * DC + col0;
                    float o[8];
#pragma unroll
                    for (int n = 0; n < 2; ++n)
#pragma unroll
                        for (int j = 0; j < 4; ++j) o[n * 4 + j] = acc[ai][0][m][n][j] * sigmoidf_fast(acc[ai][1][m][n][j]);
                    u32x4 w; w.x = cvt_pk_bf16(o[0], o[1]); w.y = cvt_pk_bf16(o[2], o[3]); w.z = cvt_pk_bf16(o[4], o[5]); w.w = cvt_pk_bf16(o[6], o[7]);
                    *(u32x4*)rowp = w; }
        }
    }
};
struct EpiResid {
    static constexpr bool PERM = true;
    const float* xf; bf16_t* X; const float* gate;
    __device__ __forceinline__ void operator()(const f32x4 (&acc)[2][2][4][2], const Unit& u, int wr, int wc, int fr, int fq) const {
        const int row0 = u.pm * BM + wr * 64 + fr, col0 = u.pn * BM + wc * 32 + 8 * fq;
        const float* g = gate + (size_t)((u.pm * BM) / SEQ) * NMOD + col0;
        f32x4 gv[2][2];
#pragma unroll
        for (int bj = 0; bj < 2; ++bj)
#pragma unroll
            for (int n = 0; n < 2; ++n) gv[bj][n] = *(const f32x4*)(g + bj * HALF + n * 4);
        if (xf) {
#pragma unroll
            for (int ai = 0; ai < 2; ++ai)
#pragma unroll
                for (int mp = 0; mp < 4; mp += 2) {
                    f32x4 xin[2][2][2];
#pragma unroll
                    for (int mm = 0; mm < 2; ++mm)
#pragma unroll
                        for (int bj = 0; bj < 2; ++bj) { const size_t ro = (size_t)(row0 + ai * HALF + (mp + mm) * 16) * DM + col0 + bj * HALF;
                            xin[mm][bj][0] = *(const f32x4*)(xf + ro); xin[mm][bj][1] = *(const f32x4*)(xf + ro + 4); }
#pragma unroll
                    for (int mm = 0; mm < 2; ++mm)
#pragma unroll
                        for (int bj = 0; bj < 2; ++bj) { const size_t ro = (size_t)(row0 + ai * HALF + (mp + mm) * 16) * DM + col0 + bj * HALF;
                            const f32x4 v0 = xin[mm][bj][0] + gv[bj][0] * acc[ai][bj][mp + mm][0], v1 = xin[mm][bj][1] + gv[bj][1] * acc[ai][bj][mp + mm][1];
                            u32x4 w; w.x = cvt_pk_bf16(v0[0], v0[1]); w.y = cvt_pk_bf16(v0[2], v0[3]); w.z = cvt_pk_bf16(v1[0], v1[1]); w.w = cvt_pk_bf16(v1[2], v1[3]);
                            *(u32x4*)(X + ro) = w; }
                }
        } else {
#pragma unroll
            for (int ai = 0; ai < 2; ++ai) {
                u32x4 ux[4][2];
#pragma unroll
                for (int m = 0; m < 4; ++m)
#pragma unroll
                    for (int bj = 0; bj < 2; ++bj) ux[m][bj] = *(const u32x4*)(X + (size_t)(row0 + ai * HALF + m * 16) * DM + col0 + bj * HALF);
#pragma unroll
                for (int m = 0; m < 4; ++m)
#pragma unroll
                    for (int bj = 0; bj < 2; ++bj) { const u32x4 t = ux[m][bj];
                        const f32x4 x0 = (f32x4){bf_lo(t.x), bf_hi(t.x), bf_lo(t.y), bf_hi(t.y)}, x1 = (f32x4){bf_lo(t.z), bf_hi(t.z), bf_lo(t.w), bf_hi(t.w)};
                        const f32x4 v0 = x0 + gv[bj][0] * acc[ai][bj][m][0], v1 = x1 + gv[bj][1] * acc[ai][bj][m][1];
                        u32x4 w; w.x = cvt_pk_bf16(v0[0], v0[1]); w.y = cvt_pk_bf16(v0[2], v0[3]); w.z = cvt_pk_bf16(v1[0], v1[1]); w.w = cvt_pk_bf16(v1[2], v1[3]);
                        *(u32x4*)(X + (size_t)(row0 + ai * HALF + m * 16) * DM + col0 + bj * HALF) = w; }
            }
        }
    }
};
struct EpiSwiglu {
    static constexpr bool PERM = true;
    bf16_t* ACT;
    __device__ __forceinline__ void operator()(const f32x4 (&acc)[2][2][4][2], const Unit& u, int wr, int wc, int fr, int fq) const {
        const int row0 = u.pm * BM + wr * 64 + fr, col0 = u.pn * HALF + wc * 32 + 8 * fq;
#pragma unroll
        for (int ai = 0; ai < 2; ++ai) { if (ai == 1 && u.half) break;
#pragma unroll
            for (int m = 0; m < 4; ++m) { bf16_t* rowp = ACT + (size_t)(row0 + ai * HALF + m * 16) * DE + col0;
                float o[8];
#pragma unroll
                for (int n = 0; n < 2; ++n)
#pragma unroll
                    for (int j = 0; j < 4; ++j) { const float g = acc[ai][0][m][n][j]; o[n * 4 + j] = g * sigmoidf_fast(g) * acc[ai][1][m][n][j]; }
                u32x4 w; w.x = cvt_pk_bf16(o[0], o[1]); w.y = cvt_pk_bf16(o[2], o[3]); w.z = cvt_pk_bf16(o[4], o[5]); w.w = cvt_pk_bf16(o[6], o[7]);
                *(u32x4*)rowp = w; } }
    }
};
struct EpiY {
    static constexpr bool PERM = true;
    bf16_t* Y;
    __device__ __forceinline__ void operator()(const f32x4 (&acc)[2][2][4][2], const Unit& u, int wr, int wc, int fr, int fq) const {
        const int row0 = u.pm * BM + wr * 64 + fr, col0 = u.pn * BM + wc * 32 + 8 * fq;
#pragma unroll
        for (int ai = 0; ai < 2; ++ai) { if (ai == 1 && u.half) break;
#pragma unroll
            for (int m = 0; m < 4; ++m) { bf16_t* rowp = Y + (size_t)(row0 + ai * HALF + m * 16) * DM + col0;
#pragma unroll
                for (int bj = 0; bj < 2; ++bj) { const f32x4 v0 = acc[ai][bj][m][0], v1 = acc[ai][bj][m][1];
                    u32x4 w; w.x = cvt_pk_bf16(v0[0], v0[1]); w.y = cvt_pk_bf16(v0[2], v0[3]); w.z = cvt_pk_bf16(v1[0], v1[1]); w.w = cvt_pk_bf16(v1[2], v1[3]);
                    *(u32x4*)(rowp + bj * HALF) = w; } } }
    }
};
}

struct Params {
    const float* in[20];
    float* out;
    unsigned char* ws;
    int ph_lo, ph_hi;
};
enum { I_X = 0, I_C, I_WMOD, I_BMOD, I_G1, I_WIN, I_CONVW, I_CONVB, I_LNG, I_LNB, I_WOUT, I_G2, I_WRG, I_BRG, I_WRE, I_BRE, I_WEG, I_WEU, I_WED, I_GF };

struct Frame {
    LAS unsigned char* lds;
    int tid, lane, wave, vcu, G;
    unsigned char* ws;
    unsigned* ctl;
};

struct CvItem { const float* W; bf16_t* WT; int K, N, k0, n0, drow0; };
__device__ __forceinline__ void cv_load(const CvItem& d, f32x4 (&v)[8], int lane) {
    const int kr = lane >> 3, nc = lane & 7;
#pragma unroll
    for (int i = 0; i < 8; ++i) v[i] = *(const f32x4*)(d.W + (size_t)(d.k0 + 8 * i + kr) * d.N + d.n0 + 4 * nc);
}
__device__ __forceinline__ void cv_finish(const CvItem& d, const f32x4 (&v)[8], LAS float* scr, int lane) {
    const int kr = lane >> 3, nc = lane & 7;
#pragma unroll
    for (int i = 0; i < 8; ++i) { LAS float* p = scr + (8 * i + kr) * 33 + 4 * nc; p[0] = v[i][0]; p[1] = v[i][1]; p[2] = v[i][2]; p[3] = v[i][3]; }
    asm volatile("s_waitcnt lgkmcnt(0)" ::: "memory");
    const int c = lane & 7;
#pragma unroll
    for (int j = 0; j < 4; ++j) { const int n = (lane >> 3) + 8 * j; const LAS float* s = scr + (8 * c) * 33 + n;
        u32x4 o; o.x = cvt_pk_bf16(s[0 * 33], s[1 * 33]); o.y = cvt_pk_bf16(s[2 * 33], s[3 * 33]); o.z = cvt_pk_bf16(s[4 * 33], s[5 * 33]); o.w = cvt_pk_bf16(s[6 * 33], s[7 * 33]);
        *(u32x4*)(d.WT + (size_t)(d.drow0 + n) * d.K + d.k0 + 8 * c) = o; }
    asm volatile("s_waitcnt lgkmcnt(0)" ::: "memory");
}
__device__ __forceinline__ int win_row(int n) {
    if (n < 1536) return n;
    const int c = n - 1536; if (c < 512) return 1536 + (c >> 7) * 256 + (c & 127);
    const int j = c - 512; return 1536 + (j >> 7) * 256 + 128 + (j & 127);
}
#ifndef CONV_CV
#define CONV_CV 1
#endif
constexpr int CV_I_IN = 16 * 80, CV_I_OUT = 16 * 32, CV_I_G = 16 * 16, CV_I_D = 8 * 32;
constexpr int CV_PER_E = 2 * CV_I_G + CV_I_D, CV_PER_L = CV_I_IN + CV_I_OUT + NE * CV_PER_E;
constexpr int CV_PER_UNIT = 2;
constexpr int CV_NDELEG = 8192 * CV_PER_UNIT, CV_REST = CV_PER_L - CV_NDELEG, CV_NP0 = CV_PER_L + (NL - 1) * CV_REST;
static_assert(CV_PER_L % 8 == 0 && CV_NDELEG % 8 == 0, "patches of 8 items");
#define CV_KN(r, NBK) const int q_ = (r) >> 3, s_ = (r) & 7, kb = 2 * (q_ / ((NBK) / 4)) + (s_ >> 2), nb = 4 * (q_ % ((NBK) / 4)) + (s_ & 3)
__device__ __forceinline__ CvItem cv_describe(const Params& P, unsigned char* ws, int it) {
    const int l = it / CV_PER_L; int r = it - l * CV_PER_L;
    if (r < CV_I_IN) { CV_KN(r, 80);
        return CvItem{P.in[opaque_s(I_WIN)] + (size_t)l * DM * DIN, (bf16_t*)(ws + WS_WIN) + (size_t)l * DIN * DM, DM, DIN, kb * 64, nb * 32, win_row(nb * 32)}; }
    r -= CV_I_IN;
    if (r < CV_I_OUT) { CV_KN(r, 32);
        return CvItem{P.in[opaque_s(I_WOUT)] + (size_t)l * DM * DM, (bf16_t*)(ws + WS_WOUT) + (size_t)l * DM * DM, DM, DM, kb * 64, nb * 32, nb * 32}; }
    r -= CV_I_OUT;
    const int e = r / CV_PER_E; r -= e * CV_PER_E; const size_t le = (size_t)l * NE + e;
    if (r < CV_I_G) { CV_KN(r, 16); const int n0 = nb * 32;
        return CvItem{P.in[opaque_s(I_WEG)] + le * DM * DE, (bf16_t*)(ws + WS_WGU) + le * DM * DM, DM, DE, kb * 64, n0, (n0 >> 7) * 256 + (n0 & 127)}; }
    r -= CV_I_G;
    if (r < CV_I_G) { CV_KN(r, 16); const int n0 = nb * 32;
        return CvItem{P.in[opaque_s(I_WEU)] + le * DM * DE, (bf16_t*)(ws + WS_WGU) + le * DM * DM, DM, DE, kb * 64, n0, (n0 >> 7) * 256 + 128 + (n0 & 127)}; }
    r -= CV_I_G;
    CV_KN(r, 32);
    return CvItem{P.in[opaque_s(I_WED)] + le * DE * DM, (bf16_t*)(ws + WS_WD) + le * DM * DE, DE, DM, kb * 64, nb * 32, nb * 32};
}
#undef CV_KN
__device__ __forceinline__ void p0_prologue(Frame& F, const Params& P) {
    {
        LAS float* cact = (LAS float*)F.lds;
        LAS float* red = (LAS float*)(F.lds + 32768);
        const float* c = P.in[I_C];
        bool have = false;
        for (int u = F.vcu; u < NL * 64; u += F.G) {
            if (!have) {
                for (int idx = F.tid; idx < NB * DM; idx += 512) { const int b = idx >> 10, k = idx & 1023; const float v = c[idx]; cact[k * 8 + b] = v / (1.0f + __expf(-v)); }
                have = true; __syncthreads();
            }
            const int l = u >> 6, cb = u & 63, kq = F.tid / 96, cn = F.tid - kq * 96, n = cb * 96 + cn;
            if (kq < 4) {
                const float* w = P.in[I_WMOD] + (size_t)l * DM * NMOD + n;
                float acc[8] = {0.f, 0.f, 0.f, 0.f, 0.f, 0.f, 0.f, 0.f};
#pragma unroll 8
                for (int k = kq * 256; k < kq * 256 + 256; ++k) {
                    const float wv = w[(size_t)k * NMOD];
                    const f32x4 a0 = *(const LAS f32x4*)(cact + k * 8), a1 = *(const LAS f32x4*)(cact + k * 8 + 4);
                    acc[0] += a0[0] * wv; acc[1] += a0[1] * wv; acc[2] += a0[2] * wv; acc[3] += a0[3] * wv;
                    acc[4] += a1[0] * wv; acc[5] += a1[1] * wv; acc[6] += a1[2] * wv; acc[7] += a1[3] * wv;
                }
#pragma unroll
                for (int b = 0; b < 8; ++b) red[(kq * 8 + b) * 96 + cn] = acc[b];
            }
            __syncthreads();
            float* mod = (float*)(F.ws + WS_MOD);
            for (int idx = F.tid; idx < 8 * 96; idx += 512) { const int b = idx / 96, cc = idx - b * 96;
                const float v = red[(0 * 8 + b) * 96 + cc] + red[(1 * 8 + b) * 96 + cc] + red[(2 * 8 + b) * 96 + cc] + red[(3 * 8 + b) * 96 + cc] + P.in[I_BMOD][(size_t)l * NMOD + cb * 96 + cc];
                mod[(size_t)(l * NB + b) * NMOD + cb * 96 + cc] = v; }
            __syncthreads();
        }
        __syncthreads();
    }
    {
        bf16_t* wr = (bf16_t*)(F.ws + WS_WR);
        const int gt = F.vcu * 512 + F.tid, ngt = F.G * 512;
        for (int idx = gt; idx < NL * 64 * DM; idx += ngt) {
            const int k = idx & 1023, n = (idx >> 10) & 63, l = idx >> 16;
            float v = 0.f;
            if (n < NE) v = P.in[I_WRE][((size_t)l * DM + k) * NE + n];
            else if (n < NE + NGRP) v = P.in[I_WRG][((size_t)l * DM + k) * NGRP + (n - NE)];
            wr[idx] = (bf16_t)(cvt_pk_bf16(v, 0.f) & 0xffffu);
        }
    }
    {
        LAS float* scr = (LAS float*)(F.lds + F.wave * 16384);
        const int gw = F.vcu * 8 + F.wave, NGW = F.G * 8;
        auto describe = [&](int c) -> CvItem {
            int it = c;
            if (c >= CV_PER_L) { const int c2 = c - CV_PER_L, l = 1 + c2 / CV_REST; it = l * CV_PER_L + CV_NDELEG + (c2 - (l - 1) * CV_REST); }
            return cv_describe(P, F.ws, it); };
        constexpr int NITEMS = CV_NP0;
        int it = gw;
        if (it < NITEMS) {
            f32x4 va[8], vb[8];
            CvItem da = describe(it), db = da;
            cv_load(da, va, F.lane);
            for (;;) {
                const int it2 = it + NGW; const bool h2 = it2 < NITEMS;
                if (h2) { db = describe(it2); cv_load(db, vb, F.lane); }
                cv_finish(da, va, scr, F.lane);
                if (!h2) break;
                const int it3 = it2 + NGW; const bool h3 = it3 < NITEMS;
                if (h3) { da = describe(it3); cv_load(da, va, F.lane); }
                cv_finish(db, vb, scr, F.lane);
                if (!h3) break;
                it = it3;
            }
        }
    }
}

template <bool ORD>
__device__ __forceinline__ void build_tables(Frame& F, int l) {
    LAS int* tpre = (LAS int*)(F.lds + LC_TPRE); LAS int* cntl = (LAS int*)(F.lds + LC_CNT); LAS int* ord = (LAS int*)(F.lds + LC_ORD);
    if (F.tid < 64) {
        const int e = F.tid & 31;
        const int c = (int)__hip_atomic_load(F.ctl + CW_CNT + l * NE + e, __ATOMIC_RELAXED, __HIP_MEMORY_SCOPE_AGENT);
        const int nt = (c + 255) >> 8, sm = (nt > 0 && c - 256 * (nt - 1) <= 128) ? 1 : 0, nfl = nt - sm;
        int pk = nt | (nfl << 10) | (sm << 20);
        int inc = pk;
        const int ol = opaque_v(F.tid & 63);
#pragma unroll
        for (int d = 1; d < 32; d <<= 1) { const int o = __builtin_amdgcn_ds_bpermute((ol - d) << 2, inc); if (e >= d) inc += o; }
        const int exc = inc - pk, tot = __builtin_amdgcn_readlane(inc, 31);
        const int tp = exc & 1023, fp = (exc >> 10) & 1023, sp = (exc >> 20) & 1023, ttot = tot & 1023, ftot = (tot >> 10) & 1023;
        if (F.tid < NE) {
            cntl[e] = c; tpre[e] = tp;
            if (e == NE - 1) { tpre[NE] = ttot; tpre[NE + 1] = ftot; }
            if (ORD) {
                for (int t = 0; t < nfl; ++t) ord[fp + t] = e | (t << 8);
                if (sm) ord[ftot + sp] = e | ((nt - 1) << 8) | (1 << 20);
            }
        }
    }
    __syncthreads();
}

template <bool FINAL>
__device__ __forceinline__ void phase_norm1(Frame& F, const Params& P, int l) {
    const int gw = F.vcu * 8 + F.wave;
    const int NGW = F.G * 8;
    const float* mod = (const float*)(F.ws + WS_MOD);
    const bool comb = FINAL || l > 0;
    const int lp = FINAL ? NL - 1 : l - 1;
    const LAS int* tpre = (const LAS int*)(F.lds + LC_TPRE);
    const int* tok_e = (const int*)(F.ws + ws_tok(lp < 0 ? 0 : lp)); const int* tok_pos = tok_e + 2 * NT; const float* tok_w = (const float*)(tok_pos + 2 * NT);
    const bf16_t* Y = (const bf16_t*)(F.ws + WS_Y);
    bf16_t* H = (bf16_t*)(F.ws + WS_H);
    bf16_t* X = (bf16_t*)(F.ws + WS_X);
    const float* xin = (!FINAL && l == 0) ? P.in[I_X] : nullptr;
    const int wpb = NGW / NB;
    if (wpb * NB != NGW) return;
    const int b = gw / wpb, w0 = gw % wpb;
    f32x4 mul[4], add[4], gt[4];
#pragma unroll
    for (int j = 0; j < 4; ++j) {
        const int col = 4 * F.lane + 256 * j;
        if (FINAL) { mul[j] = *(const f32x4*)(P.in[I_GF] + col); add[j] = (f32x4){0.f, 0.f, 0.f, 0.f}; }
        else { const f32x4 g = *(const f32x4*)(P.in[I_G1] + (size_t)l * DM + col); const float* mb = mod + (size_t)(l * NB + b) * NMOD;
            const f32x4 sc = *(const f32x4*)(mb + DM + col); mul[j] = g * (sc + 1.0f); add[j] = *(const f32x4*)(mb + col); }
        if (comb) gt[j] = *(const f32x4*)(mod + (size_t)(lp * NB + b) * NMOD + 5 * DM + col); else gt[j] = (f32x4){0.f, 0.f, 0.f, 0.f};
    }
    for (int rr = w0; rr < SEQ; rr += 2 * wpb) {
        const size_t rowA[2] = {(size_t)b * SEQ + rr, (size_t)b * SEQ + rr + wpb};
        f32x4 v[2][4];
#pragma unroll
        for (int q = 0; q < 2; ++q)
#pragma unroll
            for (int j = 0; j < 4; ++j) v[q][j] = ld_x4(xin, X, rowA[q] * DM + 4 * F.lane + 256 * j);
        if (comb) {
            size_t p0[2], p1[2]; float w0f[2], w1f[2];
#pragma unroll
            for (int q = 0; q < 2; ++q) { const size_t row = rowA[q];
                const int e0 = tok_e[row * 2], e1 = tok_e[row * 2 + 1];
                p0[q] = (size_t)tpre[e0] * 256 + tok_pos[row * 2]; p1[q] = (size_t)tpre[e1] * 256 + tok_pos[row * 2 + 1];
                w0f[q] = tok_w[row * 2]; w1f[q] = tok_w[row * 2 + 1]; }
            u32x2 ya[2][4], yc[2][4];
#pragma unroll
            for (int q = 0; q < 2; ++q)
#pragma unroll
                for (int j = 0; j < 4; ++j) { ya[q][j] = *(const u32x2*)(Y + p0[q] * DM + 4 * F.lane + 256 * j); yc[q][j] = *(const u32x2*)(Y + p1[q] * DM + 4 * F.lane + 256 * j); }
#pragma unroll
            for (int q = 0; q < 2; ++q)
#pragma unroll
                for (int j = 0; j < 4; ++j) {
                    const u32x2 a = ya[q][j], c = yc[q][j];
                    f32x4 m;
                    m[0] = w0f[q] * bf_lo(a.x) + w1f[q] * bf_lo(c.x); m[1] = w0f[q] * bf_hi(a.x) + w1f[q] * bf_hi(c.x);
                    m[2] = w0f[q] * bf_lo(a.y) + w1f[q] * bf_lo(c.y); m[3] = w0f[q] * bf_hi(a.y) + w1f[q] * bf_hi(c.y);
                    v[q][j] = v[q][j] + gt[j] * m;
                }
            if (!FINAL) {
#pragma unroll
                for (int q = 0; q < 2; ++q)
#pragma unroll
                    for (int j = 0; j < 4; ++j) st_x4(X, rowA[q] * DM + 4 * F.lane + 256 * j, v[q][j]);
            }
        }
#pragma unroll
        for (int q = 0; q < 2; ++q) {
            const size_t row = rowA[q];
            float ss = 0.f;
#pragma unroll
            for (int j = 0; j < 4; ++j) ss += (v[q][j][0] * v[q][j][0] + v[q][j][1] * v[q][j][1]) + (v[q][j][2] * v[q][j][2] + v[q][j][3] * v[q][j][3]);
            const float rinv = __builtin_amdgcn_rsqf(wave_sum(ss) * (1.0f / DM) + EPS);
            if (FINAL) {
#pragma unroll
                for (int j = 0; j < 4; ++j) *(f32x4*)(P.out + row * DM + 4 * F.lane + 256 * j) = v[q][j] * rinv * mul[j];
            } else {
#pragma unroll
                for (int j = 0; j < 4; ++j) { const f32x4 hv = v[q][j] * rinv * mul[j] + add[j];
                    u32x2 o; o.x = cvt_pk_bf16(hv[0], hv[1]); o.y = cvt_pk_bf16(hv[2], hv[3]);
                    *(u32x2*)(H + row * DM + 4 * F.lane + 256 * j) = o; }
            }
        }
    }
}

__device__ __forceinline__ s16x4 vtr(const LAS unsigned char* p) {
    typedef short v4i16_t __attribute__((ext_vector_type(4)));
    return __builtin_bit_cast(s16x4, __builtin_amdgcn_ds_read_tr16_b64_v4i16((LAS v4i16_t*)p));
}
constexpr int AT_OPITCH = 136;
constexpr int AT_OS = 0, AT_MS = 512 * AT_OPITCH, AT_LS = AT_MS + 2048, AT_VT = AT_LS + 2048;
static_assert(AT_VT + 7 * 8192 <= LDS_SCRATCH && LC_ROWTAB + 8192 <= LDS_BYTES, "attention LDS: waves 0-6 below the control words, wave 7 in the (idle) row-table area");
__device__ __forceinline__ void attn_unit(Frame& F, const bf16_t* QKV, bf16_t* MIX, int b, int h, int c8) {
    const int lane = F.lane, wid = F.wave, r32 = lane & 31, hi = lane >> 5;
    LAS unsigned char* Os = F.lds + AT_OS;
    LAS float* ms = (LAS float*)(F.lds + AT_MS);
    LAS float* ls = (LAS float*)(F.lds + AT_LS);
    LAS unsigned char* Vt = (wid < 7) ? (F.lds + AT_VT + wid * 8192) : (F.lds + LC_ROWTAB);
    LAS unsigned char* Kt = Vt + 4096;
    const LAS unsigned char* krd = Kt + r32 * 128;
    const int t0 = c8 * 512;
    const bf16_t* Qb = QKV + (size_t)b * SEQ * QKVP + h * HD;
    const bf16_t* Kb = Qb + DA; const bf16_t* Vb = Qb + 2 * DA;
    const float sl2 = exp2f(-(float)(h + 1)) * LOG2E;
    const int vq = (lane & 15) >> 2, vp = lane & 3, vg = (lane >> 4) & 1;
    const LAS unsigned char* vrd = Vt + (4 * hi + vq) * 64 + vg * 32 + vp * 8;
#define AT_STAGE_KV(KK, VV) do { _Pragma("unroll") for (int i = 0; i < 4; ++i) { const int id = lane + 64 * i, key = id >> 3, ch = id & 7; \
            *(LAS u32x4*)(Vt + (ch >> 2) * 2048 + key * 64 + (ch & 3) * 16) = VV[i]; \
            *(LAS u32x4*)(Kt + key * 128 + ((ch ^ (key & 7)) << 4)) = KK[i]; } \
        _Pragma("unroll") for (int s_ = 0; s_ < 4; ++s_) kf[s_] = *(const LAS bf16x8*)(krd + (((2 * s_ + hi) ^ (r32 & 7)) << 4)); } while (0)
#define AT_GLOAD_KV(KK, VV, IK0) do { _Pragma("unroll") for (int i = 0; i < 4; ++i) { const int id = lane + 64 * i, key = id >> 3, ch = id & 7; const size_t tv_ = (size_t)(rr + (((IK0) + key) << dsh)); \
            KK[i] = *(const u32x4*)(Kb + tv_ * QKVP + ch * 8); VV[i] = *(const u32x4*)(Vb + tv_ * QKVP + ch * 8); } } while (0)
#pragma unroll 1
    for (int st = 0; st < 3; ++st) {
        const int dsh = 2 * st, dm1 = (1 << dsh) - 1;
        const float sld = sl2 * (float)(1 << dsh);
        if (st < 2) {
            const int rr = (st == 0) ? 0 : (wid & 3);
            const int qiA = (st == 0) ? 2 * wid : 2 * (wid >> 2);
            const int iq0A = (t0 >> dsh) + 32 * qiA;
            const int qlA = rr + ((32 * qiA + r32) << dsh), qlB = rr + ((32 * (qiA + 1) + r32) << dsh);
            bf16x8 qfA[4], qfB[4];
#pragma unroll
            for (int s = 0; s < 4; ++s) { qfA[s] = *(const bf16x8*)(Qb + (size_t)(t0 + qlA) * QKVP + 16 * s + 8 * hi); qfB[s] = *(const bf16x8*)(Qb + (size_t)(t0 + qlB) * QKVP + 16 * s + 8 * hi); }
            float mA, lA, mB, lB; f32x16 oA0, oA1, oB0, oB1;
#define AT_LOAD_STATE(M, L, O0, O1, QL) do { M = ms[QL]; L = (hi == 0) ? ls[QL] : 0.f; \
                _Pragma("unroll") for (int g = 0; g < 4; ++g) { \
                    const u32x2 a_ = *(const LAS u32x2*)(Os + (QL) * AT_OPITCH + (8 * g + 4 * hi) * 2); \
                    const u32x2 c_ = *(const LAS u32x2*)(Os + (QL) * AT_OPITCH + (32 + 8 * g + 4 * hi) * 2); \
                    O0[4 * g] = bf_lo(a_.x); O0[4 * g + 1] = bf_hi(a_.x); O0[4 * g + 2] = bf_lo(a_.y); O0[4 * g + 3] = bf_hi(a_.y); \
                    O1[4 * g] = bf_lo(c_.x); O1[4 * g + 1] = bf_hi(c_.x); O1[4 * g + 2] = bf_lo(c_.y); O1[4 * g + 3] = bf_hi(c_.y); } } while (0)
#define AT_STORE_STATE(M, L, O0, O1, QL) do { const float lt_ = L + __shfl_xor(L, 32); if (hi == 0) { ms[QL] = M; ls[QL] = lt_; } \
                _Pragma("unroll") for (int g = 0; g < 4; ++g) { u32x2 a_, c_; \
                    a_.x = cvt_pk_bf16(O0[4 * g], O0[4 * g + 1]); a_.y = cvt_pk_bf16(O0[4 * g + 2], O0[4 * g + 3]); \
                    c_.x = cvt_pk_bf16(O1[4 * g], O1[4 * g + 1]); c_.y = cvt_pk_bf16(O1[4 * g + 2], O1[4 * g + 3]); \
                    *(LAS u32x2*)(Os + (QL) * AT_OPITCH + (8 * g + 4 * hi) * 2) = a_; \
                    *(LAS u32x2*)(Os + (QL) * AT_OPITCH + (32 + 8 * g + 4 * hi) * 2) = c_; } } while (0)
#define AT_QK(QF, S, CJ, MOLD, MDIAG) do { \
                const float lb_ = (CJ) - sld * (float)(r32 - 4 * hi); \
                _Pragma("unroll") for (int r = 0; r < 16; ++r) S[r] = fmaf(sld, (float)((r & 3) + 8 * (r >> 2)), lb_); \
                _Pragma("unroll") for (int s = 0; s < 4; ++s) S = __builtin_amdgcn_mfma_f32_32x32x16_bf16(kf[s], QF[s], S, 0, 0, 0); \
                if (MOLD) { const int dq_ = opaque_v(r32 - 4 * hi);     \
                    _Pragma("unroll") for (int r = 0; r < 16; ++r) if (((r & 3) + 8 * (r >> 2)) < dq_) S[r] = -1e30f; } \
                if (MDIAG) { const int dq_ = opaque_v(r32 - 4 * hi); \
                    _Pragma("unroll") for (int r = 0; r < 16; ++r) if (((r & 3) + 8 * (r >> 2)) > dq_) S[r] = -1e30f; } } while (0)
#define AT_SMPV(S, M, L, O0, O1) do { \
                float mx = S[0]; \
                _Pragma("unroll") for (int r = 1; r < 16; ++r) mx = fmaxf(mx, S[r]); \
                if (__any(mx > M + 6.0f)) { mx = fmaxf(mx, __shfl_xor(mx, 32)); const float mn = fmaxf(M, mx); const float alpha = fast_exp2(M - mn); M = mn; L *= alpha; \
                    _Pragma("unroll") for (int r = 0; r < 16; ++r) { O0[r] *= alpha; O1[r] *= alpha; } } \
                float ps = 0.f; \
                _Pragma("unroll") for (int r = 0; r < 16; ++r) { S[r] = fast_exp2(S[r] - M); ps += S[r]; } \
                L += ps; \
                u32x4 pw0, pw1; \
                pw0.x = cvt_pk_bf16(S[0], S[1]); pw0.y = cvt_pk_bf16(S[2], S[3]); pw0.z = cvt_pk_bf16(S[4], S[5]); pw0.w = cvt_pk_bf16(S[6], S[7]); \
                pw1.x = cvt_pk_bf16(S[8], S[9]); pw1.y = cvt_pk_bf16(S[10], S[11]); pw1.z = cvt_pk_bf16(S[12], S[13]); pw1.w = cvt_pk_bf16(S[14], S[15]); \
                const bf16x8 pb0 = __builtin_bit_cast(bf16x8, pw0), pb1 = __builtin_bit_cast(bf16x8, pw1); \
                O0 = __builtin_amdgcn_mfma_f32_32x32x16_bf16(vf00, pb0, O0, 0, 0, 0); O0 = __builtin_amdgcn_mfma_f32_32x32x16_bf16(vf01, pb1, O0, 0, 0, 0); \
                O1 = __builtin_amdgcn_mfma_f32_32x32x16_bf16(vf10, pb0, O1, 0, 0, 0); O1 = __builtin_amdgcn_mfma_f32_32x32x16_bf16(vf11, pb1, O1, 0, 0, 0); } while (0)
#define AT_LOADKV(J) AT_GLOAD_KV(kk, vv, iq0A - 128 + 32 * (J))
            if (st == 0) { mA = -1e30f; lA = 0.f; mB = -1e30f; lB = 0.f;
#pragma unroll
                for (int r = 0; r < 16; ++r) { oA0[r] = 0.f; oA1[r] = 0.f; oB0[r] = 0.f; oB1[r] = 0.f; } }
            else { AT_LOAD_STATE(mA, lA, oA0, oA1, qlA); AT_LOAD_STATE(mB, lB, oB0, oB1, qlB); }
            const int jstart = (iq0A >= 128) ? 0 : ((128 - iq0A) >> 5);
#pragma unroll 1
            for (int j = jstart; j < 6; ++j) {
                bf16x8 kf[4];
                { u32x4 kk[4], vv[4]; AT_LOADKV(j); AT_STAGE_KV(kk, vv); }
                const bool actA = (j <= 4), actB = (j >= 1);
                bf16x8 vf00, vf01, vf10, vf11;
                { const s16x4 a0 = vtr(vrd), a1 = vtr(vrd + 512), a2 = vtr(vrd + 1024), a3 = vtr(vrd + 1536);
                  const s16x4 b0 = vtr(vrd + 2048), b1 = vtr(vrd + 2048 + 512), b2 = vtr(vrd + 2048 + 1024), b3 = vtr(vrd + 2048 + 1536);
                  vf00 = (bf16x8){a0[0], a0[1], a0[2], a0[3], a1[0], a1[1], a1[2], a1[3]}; vf01 = (bf16x8){a2[0], a2[1], a2[2], a2[3], a3[0], a3[1], a3[2], a3[3]};
                  vf10 = (bf16x8){b0[0], b0[1], b0[2], b0[3], b1[0], b1[1], b1[2], b1[3]}; vf11 = (bf16x8){b2[0], b2[1], b2[2], b2[3], b3[0], b3[1], b3[2], b3[3]}; }
                if (actA) { f32x16 sA; AT_QK(qfA, sA, -sld * (float)(128 - 32 * j), j == 0, j == 4); AT_SMPV(sA, mA, lA, oA0, oA1); }
                f32x16 sB;
                if (actB) AT_QK(qfB, sB, -sld * (float)(160 - 32 * j), j == 1, j == 5);
                if (actB) AT_SMPV(sB, mB, lB, oB0, oB1);
            }
            AT_STORE_STATE(mA, lA, oA0, oA1, qlA); AT_STORE_STATE(mB, lB, oB0, oB1, qlB);
#undef AT_LOAD_STATE
#undef AT_STORE_STATE
#undef AT_QK
#undef AT_SMPV
#undef AT_LOADKV
        } else {
#pragma unroll 1
        for (int qq = 0; qq < 2; ++qq) {
            const int qt = wid * 2 + qq;
            const int rr = qt & dm1, qi = qt >> dsh;
            const int iq0 = (t0 >> dsh) + 32 * qi;
            const int ql = rr + ((32 * qi + r32) << dsh);
            const int tq = t0 + ql;
            bf16x8 qf[4];
#pragma unroll
            for (int s = 0; s < 4; ++s) qf[s] = *(const bf16x8*)(Qb + (size_t)tq * QKVP + 16 * s + 8 * hi);
            float m, l; f32x16 o0, o1;
            if (st == 0) {
                m = -1e30f; l = 0.f;
#pragma unroll
                for (int r = 0; r < 16; ++r) { o0[r] = 0.f; o1[r] = 0.f; }
            } else {
                m = ms[ql]; l = (hi == 0) ? ls[ql] : 0.f;
#pragma unroll
                for (int g = 0; g < 4; ++g) {
                    const u32x2 a = *(const LAS u32x2*)(Os + ql * AT_OPITCH + (8 * g + 4 * hi) * 2);
                    const u32x2 c = *(const LAS u32x2*)(Os + ql * AT_OPITCH + (32 + 8 * g + 4 * hi) * 2);
                    o0[4 * g] = bf_lo(a.x); o0[4 * g + 1] = bf_hi(a.x); o0[4 * g + 2] = bf_lo(a.y); o0[4 * g + 3] = bf_hi(a.y);
                    o1[4 * g] = bf_lo(c.x); o1[4 * g + 1] = bf_hi(c.x); o1[4 * g + 2] = bf_lo(c.y); o1[4 * g + 3] = bf_hi(c.y);
                }
            }
            const int jmin = (iq0 >= 128) ? 0 : ((128 - iq0) >> 5);
            u32x4 kk[4], vv[4];
            AT_GLOAD_KV(kk, vv, iq0 - 128 + 32 * jmin);
#pragma unroll 1
            for (int j = jmin; j < 5; ++j) {
                bf16x8 kf[4];
                AT_STAGE_KV(kk, vv);
                if (j < 4) AT_GLOAD_KV(kk, vv, iq0 - 128 + 32 * (j + 1));
                const float lb_ = -sld * (float)(128 - 32 * j) - sld * (float)(r32 - 4 * hi);
                f32x16 sacc;
#pragma unroll
                for (int r = 0; r < 16; ++r) sacc[r] = fmaf(sld, (float)((r & 3) + 8 * (r >> 2)), lb_);
#pragma unroll
                for (int s = 0; s < 4; ++s) sacc = __builtin_amdgcn_mfma_f32_32x32x16_bf16(kf[s], qf[s], sacc, 0, 0, 0);
                if (j == 0) { const int dq_ = opaque_v(r32 - 4 * hi);
#pragma unroll
                    for (int r = 0; r < 16; ++r) if (((r & 3) + 8 * (r >> 2)) < dq_) sacc[r] = -1e30f;
                }
                if (j == 4) { const int dq_ = opaque_v(r32 - 4 * hi);
#pragma unroll
                    for (int r = 0; r < 16; ++r) if (((r & 3) + 8 * (r >> 2)) > dq_) sacc[r] = -1e30f;
                }
                float mx = sacc[0];
#pragma unroll
                for (int r = 1; r < 16; ++r) mx = fmaxf(mx, sacc[r]);
                if (__any(mx > m + 6.0f)) {
                    mx = fmaxf(mx, __shfl_xor(mx, 32));
                    const float mn = fmaxf(m, mx);
                    const float alpha = fast_exp2(m - mn);
                    m = mn; l *= alpha;
#pragma unroll
                    for (int r = 0; r < 16; ++r) { o0[r] *= alpha; o1[r] *= alpha; }
                }
                float ps = 0.f;
#pragma unroll
                for (int r = 0; r < 16; ++r) { sacc[r] = fast_exp2(sacc[r] - m); ps += sacc[r]; }
                l += ps;
                u32x4 pw0, pw1;
                pw0.x = cvt_pk_bf16(sacc[0], sacc[1]); pw0.y = cvt_pk_bf16(sacc[2], sacc[3]); pw0.z = cvt_pk_bf16(sacc[4], sacc[5]); pw0.w = cvt_pk_bf16(sacc[6], sacc[7]);
                pw1.x = cvt_pk_bf16(sacc[8], sacc[9]); pw1.y = cvt_pk_bf16(sacc[10], sacc[11]); pw1.z = cvt_pk_bf16(sacc[12], sacc[13]); pw1.w = cvt_pk_bf16(sacc[14], sacc[15]);
                const bf16x8 pb0 = __builtin_bit_cast(bf16x8, pw0), pb1 = __builtin_bit_cast(bf16x8, pw1);
#pragma unroll
                for (int d0 = 0; d0 < 2; ++d0) {
                    const s16x4 a0 = vtr(vrd + d0 * 2048), a1 = vtr(vrd + d0 * 2048 + 512), a2 = vtr(vrd + d0 * 2048 + 1024), a3 = vtr(vrd + d0 * 2048 + 1536);
                    const bf16x8 vf0 = (bf16x8){a0[0], a0[1], a0[2], a0[3], a1[0], a1[1], a1[2], a1[3]};
                    const bf16x8 vf1 = (bf16x8){a2[0], a2[1], a2[2], a2[3], a3[0], a3[1], a3[2], a3[3]};
                    if (d0 == 0) { o0 = __builtin_amdgcn_mfma_f32_32x32x16_bf16(vf0, pb0, o0, 0, 0, 0); o0 = __builtin_amdgcn_mfma_f32_32x32x16_bf16(vf1, pb1, o0, 0, 0, 0); }
                    else { o1 = __builtin_amdgcn_mfma_f32_32x32x16_bf16(vf0, pb0, o1, 0, 0, 0); o1 = __builtin_amdgcn_mfma_f32_32x32x16_bf16(vf1, pb1, o1, 0, 0, 0); }
                }
            }
            const float lt = l + __shfl_xor(l, 32);
            if (st < 2) {
                if (hi == 0) { ms[ql] = m; ls[ql] = lt; }
#pragma unroll
                for (int g = 0; g < 4; ++g) {
                    u32x2 a, c;
                    a.x = cvt_pk_bf16(o0[4 * g], o0[4 * g + 1]); a.y = cvt_pk_bf16(o0[4 * g + 2], o0[4 * g + 3]);
                    c.x = cvt_pk_bf16(o1[4 * g], o1[4 * g + 1]); c.y = cvt_pk_bf16(o1[4 * g + 2], o1[4 * g + 3]);
                    *(LAS u32x2*)(Os + ql * AT_OPITCH + (8 * g + 4 * hi) * 2) = a;
                    *(LAS u32x2*)(Os + ql * AT_OPITCH + (32 + 8 * g + 4 * hi) * 2) = c;
                }
            } else {
                const float li = fast_rcp(lt);
                bf16_t* orow = MIX + ((size_t)b * SEQ + tq) * DM + h * HD;
#pragma unroll
                for (int g = 0; g < 4; ++g) {
                    u32x2 a, c;
                    a.x = cvt_pk_bf16(o0[4 * g] * li, o0[4 * g + 1] * li); a.y = cvt_pk_bf16(o0[4 * g + 2] * li, o0[4 * g + 3] * li);
                    c.x = cvt_pk_bf16(o1[4 * g] * li, o1[4 * g + 1] * li); c.y = cvt_pk_bf16(o1[4 * g + 2] * li, o1[4 * g + 3] * li);
                    *(u32x2*)(orow + 8 * g + 4 * hi) = a;
                    *(u32x2*)(orow + 32 + 8 * g + 4 * hi) = c;
                }
            }
        }
        }
        __syncthreads();
    }
#undef AT_STAGE_KV
#undef AT_GLOAD_KV
}

constexpr int CV_XS = 0, CV_OT = 64512;
static_assert(CV_OT + 32 * DC * 4 <= LDS_SCRATCH && 63 * 1024 <= CV_OT && 7 * 8448 <= 32 * DC * 4 && LC_ROWTAB + 8448 <= LDS_BYTES, "conv LDS");
__device__ __forceinline__ void conv_stage_load(const bf16_t* GLU, int unit, int tid, u32x4 (&v)[8]) {
    const int t0g = unit * 32, tloc = t0g & (SEQ - 1);
#pragma unroll
    for (int i = 0; i < 8; ++i) { const int idx = tid + 512 * i, r = idx >> 6, ch = idx & 63; const int t = tloc - 30 + r;
        v[i] = (u32x4){0u, 0u, 0u, 0u};
        if (t >= 0 && r < 62) v[i] = *(const u32x4*)(GLU + (size_t)(t0g - 30 + r) * DC + ch * 8); }
}
__device__ __forceinline__ void conv_stage_store(LAS unsigned char* xs, int tid, const u32x4 (&v)[8]) {
#pragma unroll
    for (int i = 0; i < 8; ++i) { const int idx = tid + 512 * i, r = idx >> 6, ch = idx & 63;
        if (r < 63) *(LAS u32x4*)(xs + r * 1024 + ch * 16) = v[i]; }
}
__device__ __forceinline__ void conv_stage_load_new(const bf16_t* GLU, int unit, int tid, u32x4 (&v)[4]) {
#pragma unroll
    for (int i = 0; i < 4; ++i) { const int idx = tid + 512 * i; v[i] = *(const u32x4*)(GLU + (size_t)(unit * 32 + (idx >> 6)) * DC + (idx & 63) * 8); }
}
__device__ __forceinline__ void conv_stage_shift_store(LAS unsigned char* xs, int tid, const u32x4 (&v)[4]) {
    u32x4 t[4];
#pragma unroll
    for (int i = 0; i < 4; ++i) { const int idx = tid + 512 * i; if (idx < 30 * 64) t[i] = *(const LAS u32x4*)(xs + (32 + (idx >> 6)) * 1024 + (idx & 63) * 16); }
#pragma unroll
    for (int i = 0; i < 4; ++i) { const int idx = tid + 512 * i; if (idx < 30 * 64) *(LAS u32x4*)(xs + (idx >> 6) * 1024 + (idx & 63) * 16) = t[i]; }
    __syncthreads();
#pragma unroll
    for (int i = 0; i < 4; ++i) { const int idx = tid + 512 * i; *(LAS u32x4*)(xs + (30 + (idx >> 6)) * 1024 + (idx & 63) * 16) = v[i]; }
}
__device__ __forceinline__ void conv_taps(Frame& F, const f32x2 (&wreg)[CW], const f32x2 cb2) {
    const LAS unsigned char* xs = F.lds + CV_XS; LAS unsigned char* ot = F.lds + CV_OT;
    const int cq = F.wave & 3, th = F.wave >> 2, cpair = 128 * cq + 2 * F.lane;
#pragma unroll 1
    for (int g = 0; g < 2; ++g) {
        const int ob = 16 * th + 8 * g;
        unsigned xraw[38];
#pragma unroll
        for (int r = 0; r < 38; ++r) xraw[r] = *(const LAS unsigned*)(xs + (ob + r) * 1024 + cpair * 2);
        f32x2 acc[8];
#pragma unroll
        for (int o = 0; o < 8; ++o) acc[o] = cb2;
        f32x2 xw[8];
#pragma unroll
        for (int o = 0; o < 7; ++o) xw[o] = (f32x2){bf_lo(xraw[o]), bf_hi(xraw[o])};
#pragma unroll
        for (int j = 0; j < CW; ++j) {
            xw[(j + 7) & 7] = (f32x2){bf_lo(xraw[j + 7]), bf_hi(xraw[j + 7])};
#pragma unroll
            for (int o = 0; o < 8; ++o) acc[o] = __builtin_elementwise_fma(wreg[j], xw[(j + o) & 7], acc[o]);
        }
#pragma unroll
        for (int o = 0; o < 8; ++o) *(LAS f32x2*)(ot + (ob + o) * (DC * 4) + cpair * 4) = acc[o];
    }
}
__device__ __forceinline__ void conv_ln_store(Frame& F, bf16_t* MIX, int unit, const f32x4 (&lg)[2], const f32x4 (&lb)[2]) {
    const LAS unsigned char* ot = F.lds + CV_OT;
    const int t0g = unit * 32, o0 = 4 * F.wave, c0 = 8 * F.lane;
#pragma unroll
    for (int o = 0; o < 4; ++o) {
        const f32x4 a0 = *(const LAS f32x4*)(ot + (o0 + o) * (DC * 4) + c0 * 4), a1 = *(const LAS f32x4*)(ot + (o0 + o) * (DC * 4) + c0 * 4 + 16);
        float acc[8] = {a0[0], a0[1], a0[2], a0[3], a1[0], a1[1], a1[2], a1[3]};
        float s1 = 0.f;
#pragma unroll
        for (int c = 0; c < 8; ++c) s1 += acc[c];
        const float mean = wave_sum(s1) * (1.0f / DC);
        float s2 = 0.f;
#pragma unroll
        for (int c = 0; c < 8; ++c) { acc[c] -= mean; s2 += acc[c] * acc[c]; }
        const float rstd = __builtin_amdgcn_rsqf(wave_sum(s2) * (1.0f / DC) + EPS);
        float y[8];
#pragma unroll
        for (int c = 0; c < 4; ++c) { y[c] = acc[c] * rstd * lg[0][c] + lb[0][c]; y[4 + c] = acc[4 + c] * rstd * lg[1][c] + lb[1][c]; }
#pragma unroll
        for (int c = 0; c < 8; ++c) y[c] = y[c] * sigmoidf_fast(y[c]);
        u32x4 w; w.x = cvt_pk_bf16(y[0], y[1]); w.y = cvt_pk_bf16(y[2], y[3]); w.z = cvt_pk_bf16(y[4], y[5]); w.w = cvt_pk_bf16(y[6], y[7]);
        *(u32x4*)(MIX + (size_t)(t0g + o0 + o) * DM + DA + c0) = w;
    }
}
__device__ __forceinline__ void phase_attn(Frame& F) {
    const bf16_t* QKV = (const bf16_t*)(F.ws + WS_QKV); bf16_t* MIX = (bf16_t*)(F.ws + WS_MIX);
    const int nun = NB * NH * 8, per = (nun + F.G - 1) / F.G;
#pragma unroll 1
    for (int k = 0; k < per; ++k) {
        int b, h, c8;
        if (F.G == 256) { const int j = F.vcu & 31; b = F.vcu >> 5; h = 4 * k + (j >> 3); c8 = j & 7; }
        else { const int u = F.vcu + k * F.G; if (u >= nun) break; b = u >> 6; h = (u >> 3) & 7; c8 = u & 7; }
        attn_unit(F, QKV, MIX, b, h, c8);
    }
}
__device__ __forceinline__ void phase_conv(Frame& F, const Params& P, int l) {
    const bf16_t* GLU = (const bf16_t*)(F.ws + WS_GLU); bf16_t* MIX = (bf16_t*)(F.ws + WS_MIX);
    const int nun = NT / 32, upb = (nun + F.G - 1) / F.G, u0 = F.vcu * upb;
    int u1 = u0 + upb; u1 = u1 < nun ? u1 : nun;
    if (u0 >= u1) return;
    u32x4 v[8];
    conv_stage_load(GLU, u0, F.tid, v);
    f32x2 wreg[CW]; f32x2 cb2;
    { const int cpair = 128 * (F.wave & 3) + 2 * F.lane; const float* cw = P.in[I_CONVW] + (size_t)l * CW * DC + cpair;
#pragma unroll
      for (int j = 0; j < CW; ++j) wreg[j] = *(const f32x2*)(cw + (size_t)j * DC);
      cb2 = *(const f32x2*)(P.in[I_CONVB] + (size_t)l * DC + cpair); }
    conv_stage_store(F.lds + CV_XS, F.tid, v);
    __syncthreads();
#pragma unroll 1
    for (int u = u0; u < u1; ++u) {
        const bool more = u + 1 < u1;
        f32x4 cva[CV_PER_UNIT][8];
        u32x4 vn[4];
        if (more) conv_stage_load_new(GLU, u + 1, F.tid, vn);
        if (CONV_CV && CV_PER_UNIT > 1 && l + 1 < NL) {
            const int cr1 = (opaque_s(F.vcu) * 8 + F.wave) + ((u - u0) * CV_PER_UNIT + 1) * (F.G * 8);
            if (cr1 < CV_NDELEG) { const CvItem cd = cv_describe(P, F.ws, (l + 1) * CV_PER_L + cr1); cv_load(cd, cva[1], opaque_v(F.lane)); } }
        conv_taps(F, wreg, cb2);
        const int lane2 = opaque_v(F.lane);
        const int NGW = F.G * 8, cr = (opaque_s(F.vcu) * 8 + F.wave) + (u - u0) * CV_PER_UNIT * NGW; const bool cv = CONV_CV && (l + 1 < NL) && cr + (CV_PER_UNIT - 1) * NGW < CV_NDELEG;
        if (cv) { const CvItem cd = cv_describe(P, F.ws, (l + 1) * CV_PER_L + opaque_s(cr)); cv_load(cd, cva[0], lane2); }
        f32x4 lg[2], lb[2];
#pragma unroll
        for (int i = 0; i < 2; ++i) { lg[i] = *(const f32x4*)(P.in[I_LNG] + (size_t)l * DC + 8 * lane2 + 4 * i); lb[i] = *(const f32x4*)(P.in[I_LNB] + (size_t)l * DC + 8 * lane2 + 4 * i); }
        __syncthreads();
        if (more) conv_stage_shift_store(F.lds + CV_XS, F.tid, vn);
        conv_ln_store(F, MIX, u, lg, lb);
        __syncthreads();
        if (cv) {
#pragma unroll
            for (int q = 0; q < CV_PER_UNIT; ++q) { const CvItem cd = cv_describe(P, F.ws, (l + 1) * CV_PER_L + opaque_s(cr + q * NGW));
                cv_finish(cd, cva[q], (LAS float*)((F.wave < 7) ? (F.lds + CV_OT + F.wave * 8448) : (F.lds + LC_ROWTAB)), opaque_v(F.lane)); }
            __syncthreads(); }
    }
}

constexpr int RT_PITCH = 2064;
constexpr int RT_LW = 40;
constexpr int RT_A = 0, RT_LOG = 32 * RT_PITCH, RT_LCNT = RT_LOG + 8 * 32 * RT_LW * 4, RT_LBASE = RT_LCNT + 128, RT_SEL = RT_LBASE + 128;
static_assert(RT_SEL + 4 * 6 * 32 * 4 <= LDS_SCRATCH, "router LDS");
__device__ __forceinline__ void phase_router(Frame& F, const Params& P, int l, int cslot) {
    const float* mod = (const float*)(F.ws + WS_MOD);
    bf16_t* H = (bf16_t*)(F.ws + ws_h2(l)); const bf16_t* X = (const bf16_t*)(F.ws + WS_X);
    int* tok_e = (int*)(F.ws + ws_tok(l)); int* tok_pos = tok_e + 2 * NT; float* tok_w = (float*)(tok_pos + 2 * NT);
    int* list = (int*)(F.ws + ws_list(l));
    LAS unsigned char* At = F.lds + RT_A; LAS float* logit = (LAS float*)(F.lds + RT_LOG); LAS int* lcnt = (LAS int*)(F.lds + RT_LCNT); LAS int* lbase = (LAS int*)(F.lds + RT_LBASE);
    const int lane = F.lane, w = F.wave, r32 = lane & 31, hi = lane >> 5;
    const bf16_t* wr = (const bf16_t*)(F.ws + WS_WR) + (size_t)l * 64 * DM;
    bf16x8 bfr[8][2];
#pragma unroll
    for (int s = 0; s < 8; ++s)
#pragma unroll
        for (int n2 = 0; n2 < 2; ++n2) bfr[s][n2] = *(const bf16x8*)(wr + (size_t)(32 * n2 + r32) * DM + 128 * w + 16 * s + 8 * hi);
    const int nunits = NT / 32, upb = (nunits + F.G - 1) / F.G;
    int bcur = -1; f32x4 mul[4], add[4];
#pragma unroll 1
    for (int c0 = 0; c0 < upb; c0 += 4) {
        const int ubase = F.vcu * upb + c0;
        int nu = upb - c0; nu = nu < 4 ? nu : 4; if (ubase + nu > nunits) nu = nunits - ubase;
        if (nu <= 0) break;
        if (F.tid < 32) lcnt[F.tid] = 0;
        LAS int* sel = (LAS int*)(F.lds + RT_SEL);
        u32x2 pf[4][4];
#pragma unroll
        for (int q = 0; q < 4; ++q)
#pragma unroll
            for (int j = 0; j < 4; ++j) pf[q][j] = *(const u32x2*)(X + ((size_t)ubase * 32 + 4 * w + q) * DM + 4 * lane + 256 * j);
#pragma unroll 1
        for (int ui = 0; ui < nu; ++ui) {
            {
                const int row0 = (ubase + ui) * 32, b = row0 / SEQ;
                if (b != bcur) { bcur = b;
#pragma unroll
                    for (int j = 0; j < 4; ++j) { const int col = 4 * lane + 256 * j; const f32x4 g = *(const f32x4*)(P.in[I_G2] + (size_t)l * DM + col); const float* mb = mod + (size_t)(l * NB + b) * NMOD;
                        const f32x4 sc = *(const f32x4*)(mb + 4 * DM + col); mul[j] = g * (sc + 1.0f); add[j] = *(const f32x4*)(mb + 3 * DM + col); } }
#pragma unroll
                for (int q = 0; q < 4; ++q) {
                    const int rl = 4 * w + q; const size_t row = (size_t)row0 + rl;
                    f32x4 v[4]; float ss = 0.f;
#pragma unroll
                    for (int j = 0; j < 4; ++j) { v[j] = (f32x4){bf_lo(pf[q][j].x), bf_hi(pf[q][j].x), bf_lo(pf[q][j].y), bf_hi(pf[q][j].y)}; ss += (v[j][0] * v[j][0] + v[j][1] * v[j][1]) + (v[j][2] * v[j][2] + v[j][3] * v[j][3]); }
                    const float rinv = __builtin_amdgcn_rsqf(wave_sum(ss) * (1.0f / DM) + EPS);
#pragma unroll
                    for (int j = 0; j < 4; ++j) { const f32x4 hv = v[j] * rinv * mul[j] + add[j];
                        u32x2 o; o.x = cvt_pk_bf16(hv[0], hv[1]); o.y = cvt_pk_bf16(hv[2], hv[3]);
                        *(u32x2*)(H + row * DM + 4 * lane + 256 * j) = o;
                        *(LAS u32x2*)(At + rl * RT_PITCH + (4 * lane + 256 * j) * 2) = o; }
                }
                if (ui + 1 < nu) {
#pragma unroll
                    for (int q = 0; q < 4; ++q)
#pragma unroll
                        for (int j = 0; j < 4; ++j) pf[q][j] = *(const u32x2*)(X + ((size_t)(row0 + 32) + 4 * w + q) * DM + 4 * lane + 256 * j);
                }
                __syncthreads();
                {
                    f32x16 a0, a1;
#pragma unroll
                    for (int r = 0; r < 16; ++r) { a0[r] = 0.f; a1[r] = 0.f; }
#pragma unroll
                    for (int s = 0; s < 8; ++s) {
                        const bf16x8 af = *(const LAS bf16x8*)(At + r32 * RT_PITCH + (128 * w + 16 * s + 8 * hi) * 2);
                        a0 = __builtin_amdgcn_mfma_f32_32x32x16_bf16(af, bfr[s][0], a0, 0, 0, 0);
                        a1 = __builtin_amdgcn_mfma_f32_32x32x16_bf16(af, bfr[s][1], a1, 0, 0, 0);
                    }
#pragma unroll
                    for (int r = 0; r < 16; ++r) {
                        logit[(w * 32 + crow(r, hi)) * RT_LW + r32] = a0[r];
                        if (r32 < NGRP) logit[(w * 32 + crow(r, hi)) * RT_LW + 32 + r32] = a1[r];
                    }
                }
                __syncthreads();
                if (F.tid < 32) {
                    const LAS float* lr = logit + F.tid * RT_LW;
                    float g[4]; int grp = 0;
#pragma unroll
                    for (int i = 0; i < 4; ++i) { float sacc = 0.f;
#pragma unroll
                        for (int ww = 0; ww < 8; ++ww) sacc += lr[ww * 32 * RT_LW + 32 + i];
                        g[i] = sacc + P.in[I_BRG][l * NGRP + i]; }
                    float gm = g[0];
#pragma unroll
                    for (int i = 1; i < 4; ++i) if (g[i] > gm) { gm = g[i]; grp = i; }
                    float gs = 0.f;
#pragma unroll
                    for (int i = 0; i < 4; ++i) gs += __expf(g[i] - gm);
                    const float pg = 1.0f / gs;
                    float ev[8];
#pragma unroll
                    for (int i = 0; i < 8; ++i) { float sacc = 0.f;
#pragma unroll
                        for (int ww = 0; ww < 8; ++ww) sacc += lr[ww * 32 * RT_LW + grp * 8 + i];
                        ev[i] = sacc + P.in[I_BRE][l * NE + grp * 8 + i]; }
                    int i1 = 0; float v1 = ev[0];
#pragma unroll
                    for (int i = 1; i < 8; ++i) if (ev[i] > v1) { v1 = ev[i]; i1 = i; }
                    int i2 = -1; float v2 = -3.0e38f;
#pragma unroll
                    for (int i = 0; i < 8; ++i) if (i != i1 && ev[i] > v2) { v2 = ev[i]; i2 = i; }
                    const float ex = __expf(v2 - v1);
                    const int e0 = grp * 8 + i1, e1 = grp * 8 + i2;
                    LAS int* sl = sel + ui * 192 + F.tid;
                    sl[0] = e0; sl[32] = e1;
                    sl[64] = __hip_atomic_fetch_add(lcnt + e0, 1, __ATOMIC_RELAXED, __HIP_MEMORY_SCOPE_WORKGROUP);
                    sl[96] = __hip_atomic_fetch_add(lcnt + e1, 1, __ATOMIC_RELAXED, __HIP_MEMORY_SCOPE_WORKGROUP);
                    sl[128] = __float_as_int(pg / (1.0f + ex)); sl[160] = __float_as_int(pg * ex / (1.0f + ex));
                }
            }
        }
        __syncthreads();
        if (F.tid < 32) { const int c = lcnt[F.tid]; lbase[F.tid] = c ? (int)__hip_atomic_fetch_add(F.ctl + CW_CNT + cslot * NE + F.tid, (unsigned)c, __ATOMIC_RELAXED, __HIP_MEMORY_SCOPE_AGENT) : 0; }
        __syncthreads();
        if (F.tid < 32) {
#pragma unroll 1
            for (int ui = 0; ui < nu; ++ui) {
                const LAS int* sl = sel + ui * 192 + F.tid;
                const int tok = (ubase + ui) * 32 + F.tid; const int e0 = sl[0], e1 = sl[32], p0 = lbase[e0] + sl[64], p1 = lbase[e1] + sl[96];
                tok_e[tok * 2] = e0; tok_e[tok * 2 + 1] = e1; tok_pos[tok * 2] = p0; tok_pos[tok * 2 + 1] = p1; tok_w[tok * 2] = __int_as_float(sl[128]); tok_w[tok * 2 + 1] = __int_as_float(sl[160]);
                __hip_atomic_store(list + e0 * LCAP + p0, tok, __ATOMIC_RELAXED, __HIP_MEMORY_SCOPE_AGENT);
                __hip_atomic_store(list + e1 * LCAP + p1, tok, __ATOMIC_RELAXED, __HIP_MEMORY_SCOPE_AGENT);
            }
        }
        __syncthreads();
    }
}

constexpr int NPHASE = 2 + 7 * NL;
__global__ void __launch_bounds__(512, 2) hybrid_fwd(Params P) {
    extern __shared__ __attribute__((aligned(16))) unsigned char lds_raw[];
    Frame F;
    F.lds = (LAS unsigned char*)lds_raw;
    F.tid = threadIdx.x; F.lane = F.tid & 63; F.wave = __builtin_amdgcn_readfirstlane(F.tid >> 6);
    F.G = gridDim.x; { const int bx = blockIdx.x; F.vcu = (F.G % 8 == 0) ? (bx % 8) * (F.G / 8) + bx / 8 : bx; }
    F.ws = P.ws; F.ctl = (unsigned*)(P.ws + WS_CTL);
    if (F.tid < 4) ((LAS unsigned*)(F.lds + LC_BAR))[F.tid] = 0u;
    __syncthreads();
    XcdBarrier bar = xcd_barrier_post(F.ctl + CW_BAR, (volatile LAS unsigned*)(F.lds + LC_BAR));
    const int lo = P.ph_lo, hi = P.ph_hi;
#ifndef PH_ENABLE
#define PH_ENABLE 0x3FF
#endif
#ifndef SPLIT_TAIL
#define SPLIT_TAIL 1
#endif
#ifndef QUAD_SEAM
#define QUAD_SEAM 1
#endif
#define EN(b) ((PH_ENABLE >> (b)) & 1)
#ifndef DUP_MASK
#define DUP_MASK 0
#endif
#define NREP(b) (opaque_s((DUP_MASK >> (b)) & 1) + 1)
#define IN(k) (lo <= (k) && (k) < hi)
#ifdef PROBE_2BAR
#define SEAM(k) do { if (IN(k) && IN((k) + 1)) { xcd_barrier(bar); xcd_barrier(bar); } } while (0)
#else
#define SEAM(k) do { if (IN(k) && IN((k) + 1)) xcd_barrier(bar); } while (0)
#endif
#define FRESH() do { F.tid = opaque_v((int)threadIdx.x); F.lane = F.tid & 63; F.wave = __builtin_amdgcn_readfirstlane(F.tid >> 6); } while (0)
    if (EN(0) && IN(0)) { const int nr = NREP(0);
#pragma unroll 1
        for (int rep = 0; rep < nr; ++rep) { FRESH(); p0_prologue(F, P); } }
    SEAM(0);
    float* mod = (float*)(F.ws + WS_MOD);
#pragma unroll 1
    for (int l = 0; l < NL; ++l) {
        const int pb = 1 + 7 * l;
        if (EN(1) && IN(pb + 0)) { FRESH(); if (l > 0 && !(EN(7) && IN(pb - 1))) build_tables<false>(F, l - 1);
            phase_norm1<false>(F, P, l); }
        SEAM(pb + 0);
        if (EN(2) && IN(pb + 1)) { const int nr = NREP(2);
#pragma unroll 1
          for (int rep = 0; rep < nr; ++rep) { FRESH();
            pg8::DenseOrder S; S.init(NT, DIN, DM, F.G, (int)blockIdx.x, F.ws + WS_WIN + (size_t)l * DIN * DM * 2);
            pg8::EpiIn E{(bf16_t*)(F.ws + WS_QKV), (bf16_t*)(F.ws + WS_GLU)};
            pg8::gemm_phase<pg8::EpiIn, pg8::DenseOrder>(F.lds, S, E, (const char*)(F.ws + WS_H), DM, F.tid);
          } }
        SEAM(pb + 1);
        if (IN(pb + 2)) { const int nr3 = NREP(3), nr9 = NREP(9);
#pragma unroll 1
            for (int rep = 0; rep < nr3; ++rep) { FRESH(); phase_attn(F); }
#pragma unroll 1
            for (int rep = 0; rep < nr9; ++rep) { FRESH(); phase_conv(F, P, l); } }
        SEAM(pb + 2);
        if (EN(4) && IN(pb + 3)) { FRESH();
            pg8::DenseOrder S; S.init(NT, DM, DM, F.G, (int)blockIdx.x, F.ws + WS_WOUT + (size_t)l * DM * DM * 2);
            pg8::EpiResid E{l == 0 ? P.in[I_X] : nullptr, (bf16_t*)(F.ws + WS_X), mod + (size_t)l * NB * NMOD + 2 * DM};
            pg8::gemm_phase<pg8::EpiResid, pg8::DenseOrder>(F.lds, S, E, (const char*)(F.ws + WS_MIX), DM, F.tid);
        }
        SEAM(pb + 3);
        if (EN(5) && IN(pb + 4)) {
            if (NREP(5) > 1) { FRESH(); phase_router(F, P, l, NL + l); __syncthreads(); }
            FRESH(); phase_router(F, P, l, l); }
        SEAM(pb + 4);
        if (EN(6) && IN(pb + 5)) { const int nr = NREP(6);
#pragma unroll 1
          for (int rep = 0; rep < nr; ++rep) { FRESH();
            build_tables<true>(F, l);
            const LAS int* tpre = (const LAS int*)(F.lds + LC_TPRE); const LAS int* cntl = (const LAS int*)(F.lds + LC_CNT); LAS int* rowtab = (LAS int*)(F.lds + LC_ROWTAB);
            pg8::MoeOrder<true> S{tpre, rowtab, 4, F.G, F.vcu, DM, (const char*)(F.ws + WS_WGU + (size_t)l * NE * DM * DM * 2), (size_t)DM * DM * 2, (const LAS int*)(F.lds + LC_ORD), 0, 0, 0, 0, nullptr};
            S.init_order();
            if (SPLIT_TAIL) S.T4 = S.C4;
            int* list = (int*)(F.ws + ws_list(l));
            if (F.tid < 256) {
                int rv[MAXU];
#pragma unroll
                for (int i = 0; i < MAXU; ++i) { pg8::Unit u; rv[i] = -1;
                    if (S.next(i, u)) { const int tl = u.pm - tpre[u.e], cn = cntl[u.e]; int p = tl * 256 + F.tid; p = p < cn ? p : cn - 1;
                        rv[i] = __hip_atomic_load(list + u.e * LCAP + p, __ATOMIC_RELAXED, __HIP_MEMORY_SCOPE_AGENT); } }
#pragma unroll
                for (int i = 0; i < MAXU; ++i) if (rv[i] >= 0) rowtab[i * 256 + F.tid] = rv[i];
            }
            __syncthreads();
            pg8::EpiSwiglu E{(bf16_t*)(F.ws + ws_act(l))};
            pg8::gemm_phase<pg8::EpiSwiglu, pg8::MoeOrder<true>>(F.lds, S, E, (const char*)(F.ws + ws_h2(l)), DM, F.tid);
          } }
        if (IN(pb + 5) && IN(pb + 6)) { if (QUAD_SEAM && SPLIT_TAIL) quad_barrier(F.ctl, F.vcu, (unsigned)l, bar.w0); else xcd_barrier(bar); }
        if (EN(7) && IN(pb + 6)) { const int nr = NREP(7);
#pragma unroll 1
          for (int rep = 0; rep < nr; ++rep) { FRESH();
            if (rep > 0 || !(EN(6) && IN(pb + 5))) build_tables<true>(F, l);
            const LAS int* tpre = (const LAS int*)(F.lds + LC_TPRE);
            if (SPLIT_TAIL) {
                const LAS int* cntl = (const LAS int*)(F.lds + LC_CNT); LAS int* rowtab = (LAS int*)(F.lds + LC_ROWTAB);
                pg8::MoeOrder<true> S2{tpre, rowtab, 4, F.G, F.vcu, DM, (const char*)(F.ws + WS_WGU + (size_t)l * NE * DM * DM * 2), (size_t)DM * DM * 2, (const LAS int*)(F.lds + LC_ORD), 0, 0, 0, 0, nullptr};
                S2.init_order(); S2.nfu = 0;
                pg8::Unit u;
                if (S2.next(0, u)) {
                    const int* list = (const int*)(F.ws + ws_list(l));
                    if (F.tid < 256) { const int tl = u.pm - tpre[u.e], cn = cntl[u.e]; int p = tl * 256 + F.tid; p = p < cn ? p : cn - 1;
                        rowtab[F.tid] = __hip_atomic_load(list + u.e * LCAP + p, __ATOMIC_RELAXED, __HIP_MEMORY_SCOPE_AGENT); }
                    __syncthreads();
                    pg8::EpiSwiglu E2{(bf16_t*)(F.ws + ws_act(l))};
                    pg8::gemm_phase<pg8::EpiSwiglu, pg8::MoeOrder<true>>(F.lds, S2, E2, (const char*)(F.ws + ws_h2(l)), DM, F.tid);
                    if (F.tid == 0) {
                        __builtin_amdgcn_fence(__ATOMIC_RELEASE, "agent");
                        __hip_atomic_fetch_add(F.ctl + CW_FLAG + l * 64 + (S2.tmap >> 2), 1u, __ATOMIC_RELAXED, __HIP_MEMORY_SCOPE_AGENT);
                    }
                }
            }
            pg8::MoeOrder<false> S{tpre, nullptr, 4, F.G, F.vcu, DE, (const char*)(F.ws + WS_WD + (size_t)l * NE * DM * DE * 2), (size_t)DM * DE * 2, (const LAS int*)(F.lds + LC_ORD), 0, 0, 0, 0, nullptr};
            S.init_order();
            if (SPLIT_TAIL) { S.tmap = (S.tmap + F.G / 2) % F.G; S.flags = F.ctl + CW_FLAG + l * 64; }
            pg8::EpiY E{(bf16_t*)(F.ws + WS_Y)};
            pg8::gemm_phase<pg8::EpiY, pg8::MoeOrder<false>>(F.lds, S, E, (const char*)(F.ws + ws_act(l)), DE, F.tid);
          } }
        SEAM(pb + 6);
    }
    if (EN(8) && IN(NPHASE - 1)) { const int nr = NREP(8);
#pragma unroll 1
        for (int rep = 0; rep < nr; ++rep) { FRESH(); if (rep > 0 || !(EN(7) && IN(NPHASE - 2))) build_tables<false>(F, NL - 1); phase_norm1<true>(F, P, 0); } }
#undef IN
#undef SEAM
}

#ifndef N_LAUNCH_MODE
#define N_LAUNCH_MODE 0
#endif
extern "C" void kernel_launch(void* const* d_in, const int* in_sizes, int n_in, void* d_out, int out_size, void* d_ws, size_t ws_size, hipStream_t stream) {
    static int grid = 0;
    if (grid == 0) {
        if (n_in != 20 || out_size != NT * DM || ws_size < WS_END) { fprintf(stderr, "kernel_launch: unexpected shapes (n_in %d out %d ws %zu)\n", n_in, out_size, ws_size); grid = -1; return; }
        int dev = 0, cus = 0, per_cu = 0;
        if (hipGetDevice(&dev) != hipSuccess || hipDeviceGetAttribute(&cus, hipDeviceAttributeMultiprocessorCount, dev) != hipSuccess) { grid = -1; return; }
        if (hipFuncSetAttribute((const void*)hybrid_fwd, hipFuncAttributeMaxDynamicSharedMemorySize, LDS_BYTES) != hipSuccess) { fprintf(stderr, "kernel_launch: hipFuncSetAttribute failed\n"); grid = -1; return; }
        if (hipOccupancyMaxActiveBlocksPerMultiprocessor(&per_cu, (const void*)hybrid_fwd, 512, LDS_BYTES) != hipSuccess || per_cu < 1)
            fprintf(stderr, "kernel_launch: occupancy query reports %d\n", per_cu);
        (void)hipGetLastError();
        grid = cus;
        if (grid > 256) grid = 256;
    }
    if (grid < 0) return;
    (void)hipMemsetAsync((char*)d_ws + WS_CTL, 0, CTL_BYTES, stream);
    Params p{};
    for (int i = 0; i < 20; ++i) p.in[i] = (const float*)d_in[i];
    p.out = (float*)d_out; p.ws = (unsigned char*)d_ws;
#if N_LAUNCH_MODE == 0
    p.ph_lo = 0; p.ph_hi = NPHASE;
    hipLaunchKernelGGL(hybrid_fwd, dim3(grid), dim3(512), LDS_BYTES, stream, p);
#else
#ifndef STOP_AFTER
#define STOP_AFTER NPHASE
#endif
    const int k_first = 0;
    for (int k = k_first; k < STOP_AFTER; ++k) { p.ph_lo = k; p.ph_hi = k + 1; hipLaunchKernelGGL(hybrid_fwd, dim3(grid), dim3(512), LDS_BYTES, stream, p); }
#endif
}
```
